# Optimizing an MI355X kernel written in HIP

```python
import jax, jax.numpy as jnp
from jax import lax
import numpy as np

D_MODEL = 2048
BATCH = 1
SEQ = 16384
DEPTH = 1

CHUNK = 64
N_MEM = 256
RMS_EPS = 1e-6

RW_HEADS = 16
RW_HEAD_DIM = 64
RW_WIDTH = RW_HEADS * RW_HEAD_DIM
RW_DECAY_LORA = 64
RW_AAA_LORA = 64
RW_GATE_LORA = 160
RW_GN_EPS = 64e-5
RW_COLS = 3 * RW_WIDTH + RW_DECAY_LORA + RW_AAA_LORA + RW_GATE_LORA

GDN_QK_HEADS = 4
GDN_V_HEADS = 8
GDN_HEAD_DIM = 128
GDN_QK_WIDTH = GDN_QK_HEADS * GDN_HEAD_DIM
GDN_V_WIDTH = GDN_V_HEADS * GDN_HEAD_DIM
GDN_CONV = 4
GDN_CONV_CH = 2 * GDN_QK_WIDTH + GDN_V_WIDTH
GDN_COLS = GDN_CONV_CH + GDN_V_WIDTH + 2 * GDN_V_HEADS

N_BRANCH = 2
BRANCH_WIDTH = 1024
GATE_COLS = N_BRANCH * D_MODEL
IN_COLS = RW_COLS + GDN_COLS + GATE_COLS

MEM_HEADS = 4
MEM_HEAD_DIM = D_MODEL // MEM_HEADS

D_FF = 5632

kernel_name = "rwkv7_gdn_macaron_hybrid"


def _split(t, sizes):
    return jnp.split(t, [int(s) for s in np.cumsum(sizes)[:-1]], axis=-1)


def _rmsnorm(x, g, eps=RMS_EPS):
    xf = x.astype(jnp.float32)
    y = xf * lax.rsqrt(jnp.mean(xf * xf, axis=-1, keepdims=True) + eps)
    return (y * g.astype(jnp.float32)).astype(x.dtype)


def _l2norm(x, eps=1e-6):
    xf = x.astype(jnp.float32)
    return xf * lax.rsqrt(jnp.sum(xf * xf, axis=-1, keepdims=True) + eps)


def _swiglu_ffn(x, norm_g, w_gate, w_up, w_down):
    h = _rmsnorm(x, norm_g)
    return (jax.nn.silu(h @ w_gate) * (h @ w_up)) @ w_down


def _token_shift(x):
    return jnp.pad(x, ((0, 0), (1, 0), (0, 0)))[:, :-1]


def _causal_depthwise_conv(x, w):
    K, C = w.shape
    return lax.conv_general_dilated(
        x, w[:, None, :], window_strides=(1,), padding=[(K - 1, 0)],
        dimension_numbers=("NWC", "WIO", "NWC"), feature_group_count=C)


def _rwkv7_recurrence(r, w, k, v, a, b):
    B_, T, H, N = r.shape

    def step(S, inp):
        r_t, w_t, k_t, v_t, a_t, b_t = inp
        sa = jnp.einsum("bhij,bhj->bhi", S, a_t)
        S = S * w_t[:, :, None, :] + sa[..., None] * b_t[:, :, None, :] + v_t[..., None] * k_t[:, :, None, :]
        return S, jnp.einsum("bhij,bhj->bhi", S, r_t)

    xs = tuple(jnp.moveaxis(t, 1, 0) for t in (r, w, k, v, a, b))
    _, y = lax.scan(step, jnp.zeros((B_, H, N, N), jnp.float32), xs)
    return jnp.moveaxis(y, 0, 1)


def _rwkv7_branch(cols, shift_mu, w0, w2, a0, a2, g2, k_k, k_a, r_k, ln_w, ln_b):
    B_, T, _ = cols.shape
    cols = cols + (_token_shift(cols) - cols) * shift_mu
    r, k, v, wl, al, gl = _split(cols, (RW_WIDTH, RW_WIDTH, RW_WIDTH, RW_DECAY_LORA, RW_AAA_LORA, RW_GATE_LORA))
    w_log = -jax.nn.softplus(-(w0 + jnp.tanh(wl) @ w2)) - 0.5
    a = jax.nn.sigmoid(a0 + al @ a2)
    g = jax.nn.sigmoid(gl) @ g2

    def heads(t):
        return t.reshape(B_, T, RW_HEADS, RW_HEAD_DIM).astype(jnp.float32)

    kk = _l2norm(heads(k * k_k))
    k = k * (1 + (a - 1) * k_a)
    r_h, k_h, v_h, a_h = heads(r), heads(k), heads(v), heads(a)
    decay = jnp.exp(-jnp.exp(heads(w_log)))
    y = _rwkv7_recurrence(r_h, decay, k_h, v_h, -kk, kk * a_h)
    mu = jnp.mean(y, axis=-1, keepdims=True)
    var = jnp.mean(jnp.square(y - mu), axis=-1, keepdims=True)
    y = ((y - mu) * lax.rsqrt(var + RW_GN_EPS)).reshape(B_, T, RW_WIDTH)
    y = y * ln_w.astype(jnp.float32) + ln_b.astype(jnp.float32)
    bonus = jnp.sum(r_h * k_h * r_k.astype(jnp.float32), axis=-1, keepdims=True) * v_h
    y = y + bonus.reshape(B_, T, RW_WIDTH)
    return (y * g.astype(jnp.float32)).astype(cols.dtype)


def _chunked_gated_delta_rule(q, k, v, g, beta):
    B_, T, H, Dk = q.shape
    Dv = v.shape[-1]
    nc = T // CHUNK

    def to_chunks(t):
        return t.reshape((B_, nc, CHUNK, H) + t.shape[3:]).swapaxes(2, 3)

    q, k, v, g, beta = map(to_chunks, (q, k, v, g, beta))
    gc = jnp.cumsum(g, axis=-1)
    idx = jnp.arange(CHUNK)
    lower = idx[:, None] >= idx[None, :]
    strict = idx[:, None] > idx[None, :]
    diff = gc[..., :, None] - gc[..., None, :]
    decay = jnp.where(lower, jnp.exp(jnp.where(lower, diff, 0.0)), 0.0)
    k_beta = k * beta[..., None]
    v_beta = v * beta[..., None]
    m = jnp.where(strict, jnp.einsum("bnhid,bnhjd->bnhij", k_beta, k) * decay, 0.0)
    tri = m + jnp.eye(CHUNK, dtype=m.dtype)
    u = lax.linalg.triangular_solve(tri, v_beta, left_side=True, lower=True, unit_diagonal=True)
    w = lax.linalg.triangular_solve(tri, k_beta * jnp.exp(gc)[..., None], left_side=True, lower=True, unit_diagonal=True)
    a_qk = jnp.where(lower, jnp.einsum("bnhid,bnhjd->bnhij", q, k) * decay, 0.0)

    def step(S, inp):
        q_c, k_c, u_c, w_c, a_c, gc_c = inp
        v_new = u_c - jnp.einsum("bhld,bhde->bhle", w_c, S)
        o = (jnp.einsum("bhld,bhde->bhle", q_c * jnp.exp(gc_c)[..., None], S)
             + jnp.einsum("bhij,bhje->bhie", a_c, v_new))
        g_last = gc_c[..., -1]
        S = (S * jnp.exp(g_last)[..., None, None]
             + jnp.einsum("bhld,bhle->bhde", k_c * jnp.exp(g_last[..., None] - gc_c)[..., None], v_new))
        return S, o

    xs = tuple(jnp.moveaxis(t, 1, 0) for t in (q, k, u, w, a_qk, gc))
    _, o = lax.scan(step, jnp.zeros((B_, H, Dk, Dv), jnp.float32), xs)
    return o.transpose(1, 0, 3, 2, 4).reshape(B_, T, H, Dv)


def _gdn_branch(cols, conv_w, a_log, dt_bias, norm_w):
    B_, T, _ = cols.shape
    qkv, z, b_raw, a_raw = _split(cols, (GDN_CONV_CH, GDN_V_WIDTH, GDN_V_HEADS, GDN_V_HEADS))
    qkv = jax.nn.silu(_causal_depthwise_conv(qkv.astype(jnp.float32), conv_w.astype(jnp.float32)))
    q, k, v = _split(qkv, (GDN_QK_WIDTH, GDN_QK_WIDTH, GDN_V_WIDTH))
    rep = GDN_V_HEADS // GDN_QK_HEADS
    q = jnp.repeat(_l2norm(q.reshape(B_, T, GDN_QK_HEADS, GDN_HEAD_DIM)), rep, axis=2) * (GDN_HEAD_DIM ** -0.5)
    k = jnp.repeat(_l2norm(k.reshape(B_, T, GDN_QK_HEADS, GDN_HEAD_DIM)), rep, axis=2)
    v = v.reshape(B_, T, GDN_V_HEADS, GDN_HEAD_DIM)
    beta = jax.nn.sigmoid(b_raw.astype(jnp.float32))
    g = -jnp.exp(a_log.astype(jnp.float32)) * jax.nn.softplus(a_raw.astype(jnp.float32) + dt_bias.astype(jnp.float32))
    o = _chunked_gated_delta_rule(q, k, v, g, beta)
    z = z.reshape(B_, T, GDN_V_HEADS, GDN_HEAD_DIM).astype(jnp.float32)
    o = o * lax.rsqrt(jnp.mean(o * o, axis=-1, keepdims=True) + RMS_EPS) * norm_w.astype(jnp.float32) * jax.nn.silu(z)
    return o.reshape(B_, T, GDN_V_WIDTH).astype(cols.dtype)


def _memory_cross_attention(h, mem, q_norm, kv_norm, w_mq, w_mk, w_mv, w_mo):
    B_, T, _ = h.shape
    hq = _rmsnorm(h, q_norm)
    mkv = _rmsnorm(mem, kv_norm)
    q = (hq @ w_mq).reshape(B_, T, MEM_HEADS, MEM_HEAD_DIM)
    k = (mkv @ w_mk).reshape(B_, -1, MEM_HEADS, MEM_HEAD_DIM)
    v = (mkv @ w_mv).reshape(B_, -1, MEM_HEADS, MEM_HEAD_DIM)
    s = jnp.einsum("bthd,bmhd->bhtm", q, k).astype(jnp.float32) * (MEM_HEAD_DIM ** -0.5)
    p = jax.nn.softmax(s, axis=-1).astype(v.dtype)
    o = jnp.einsum("bhtm,bmhd->bthd", p, v).reshape(B_, T, D_MODEL)
    return o @ w_mo


def setup_inputs(seed: int = 0) -> dict:
    key = jax.random.key(seed)
    ks = iter(jax.random.split(key, 48))
    L = DEPTH

    def nrm(shape, scale):
        return jax.random.normal(next(ks), shape, jnp.float32) * scale

    def gain(shape):
        return 1.0 + nrm(shape, 0.02)

    def unif(shape, lo, hi):
        return jax.random.uniform(next(ks), shape, jnp.float32, lo, hi)

    dt = jnp.exp(unif((L, GDN_V_HEADS), float(np.log(1e-3)), float(np.log(1e-1))))
    return {
        "x": nrm((BATCH, SEQ, D_MODEL), 1.0),
        "mem": nrm((BATCH, N_MEM, D_MODEL), 1.0),
        "ffn1_norm": gain((L, D_MODEL)),
        "ffn1_w_gate": nrm((L, D_MODEL, D_FF), D_MODEL ** -0.5),
        "ffn1_w_up": nrm((L, D_MODEL, D_FF), D_MODEL ** -0.5),
        "ffn1_w_down": nrm((L, D_FF, D_MODEL), D_FF ** -0.5),
        "mix_norm": gain((L, D_MODEL)),
        "w_in": nrm((L, D_MODEL, IN_COLS), D_MODEL ** -0.5),
        "rw_shift_mu": unif((L, RW_COLS), 0.0, 1.0),
        "rw_w0": unif((L, RW_WIDTH), -6.0, -1.0),
        "rw_w2": nrm((L, RW_DECAY_LORA, RW_WIDTH), 0.1 * RW_DECAY_LORA ** -0.5),
        "rw_a0": nrm((L, RW_WIDTH), 0.1),
        "rw_a2": nrm((L, RW_AAA_LORA, RW_WIDTH), 0.1 * RW_AAA_LORA ** -0.5),
        "rw_g2": nrm((L, RW_GATE_LORA, RW_WIDTH), RW_GATE_LORA ** -0.5),
        "rw_k_k": 0.85 + nrm((L, RW_WIDTH), 0.02),
        "rw_k_a": 1.0 + nrm((L, RW_WIDTH), 0.02),
        "rw_r_k": nrm((L, RW_HEADS, RW_HEAD_DIM), 0.1),
        "rw_ln_w": gain((L, RW_WIDTH)),
        "rw_ln_b": nrm((L, RW_WIDTH), 0.01),
        "gdn_conv_w": nrm((L, GDN_CONV, GDN_CONV_CH), GDN_CONV ** -0.5),
        "gdn_a_log": jnp.log(unif((L, GDN_V_HEADS), 1.0, 16.0)),
        "gdn_dt_bias": dt + jnp.log(-jnp.expm1(-dt)),
        "gdn_norm_w": gain((L, GDN_HEAD_DIM)),
        "w_lift": nrm((L, N_BRANCH, BRANCH_WIDTH, D_MODEL), BRANCH_WIDTH ** -0.5),
        "w_out": nrm((L, D_MODEL, D_MODEL), D_MODEL ** -0.5),
        "mem_q_norm": gain((L, D_MODEL)),
        "mem_kv_norm": gain((L, D_MODEL)),
        "w_mq": nrm((L, D_MODEL, D_MODEL), D_MODEL ** -0.5),
        "w_mk": nrm((L, D_MODEL, D_MODEL), D_MODEL ** -0.5),
        "w_mv": nrm((L, D_MODEL, D_MODEL), D_MODEL ** -0.5),
        "w_mo": nrm((L, D_MODEL, D_MODEL), D_MODEL ** -0.5),
        "ffn2_norm": gain((L, D_MODEL)),
        "ffn2_w_gate": nrm((L, D_MODEL, D_FF), D_MODEL ** -0.5),
        "ffn2_w_up": nrm((L, D_MODEL, D_FF), D_MODEL ** -0.5),
        "ffn2_w_down": nrm((L, D_FF, D_MODEL), D_FF ** -0.5),
        "final_norm": gain((D_MODEL,)),
    }


def reference(x, mem, ffn1_norm, ffn1_w_gate, ffn1_w_up, ffn1_w_down,
              mix_norm, w_in, rw_shift_mu, rw_w0, rw_w2, rw_a0, rw_a2, rw_g2,
              rw_k_k, rw_k_a, rw_r_k, rw_ln_w, rw_ln_b,
              gdn_conv_w, gdn_a_log, gdn_dt_bias, gdn_norm_w,
              w_lift, w_out,
              mem_q_norm, mem_kv_norm, w_mq, w_mk, w_mv, w_mo,
              ffn2_norm, ffn2_w_gate, ffn2_w_up, ffn2_w_down, final_norm):
    B_, T, _ = x.shape
    h = x
    for l in range(DEPTH):
        h = h + 0.5 * _swiglu_ffn(h, ffn1_norm[l], ffn1_w_gate[l], ffn1_w_up[l], ffn1_w_down[l])
        u = _rmsnorm(h, mix_norm[l])
        proj = u @ w_in[l]
        rw_cols, gdn_cols, gate_cols = _split(proj, (RW_COLS, GDN_COLS, GATE_COLS))
        y_rw = _rwkv7_branch(rw_cols, rw_shift_mu[l], rw_w0[l], rw_w2[l], rw_a0[l], rw_a2[l], rw_g2[l],
                             rw_k_k[l], rw_k_a[l], rw_r_k[l], rw_ln_w[l], rw_ln_b[l])
        y_gdn = _gdn_branch(gdn_cols, gdn_conv_w[l], gdn_a_log[l], gdn_dt_bias[l], gdn_norm_w[l])
        gates = jax.nn.sigmoid(gate_cols.reshape(B_, T, N_BRANCH, D_MODEL))
        merged = (gates[:, :, 0] * (y_rw @ w_lift[l, 0])
                  + gates[:, :, 1] * (y_gdn @ w_lift[l, 1]))
        h = h + merged @ w_out[l]
        h = h + _memory_cross_attention(h, mem, mem_q_norm[l], mem_kv_norm[l], w_mq[l], w_mk[l], w_mv[l], w_mo[l])
        h = h + 0.5 * _swiglu_ffn(h, ffn2_norm[l], ffn2_w_gate[l], ffn2_w_up[l], ffn2_w_down[l])
    return _rmsnorm(h, final_norm)
```

```cpp
#include <hip/hip_runtime.h>
#include <hip/hip_cooperative_groups.h>
#include <cstdio>
namespace cg = cooperative_groups;


#define LAS __attribute__((address_space(3)))
typedef unsigned short bf16_t;
typedef short bf16x8 __attribute__((ext_vector_type(8)));
typedef float f32x4 __attribute__((ext_vector_type(4)));
typedef float f32x2 __attribute__((ext_vector_type(2)));
typedef unsigned u32x2 __attribute__((ext_vector_type(2)));
typedef unsigned u32x4 __attribute__((ext_vector_type(4)));

constexpr int T = 16384, D = 2048, DFF = 5632, PLD = 6656, NMEM = 256;
constexpr int BM = 256, BK = 64, HALF = 128, HTB = HALF * BK * 2, STAGE_BYTES = 8 * HTB, NXCD = 8, WGM = 4;
constexpr int LDS_BYTES = STAGE_BYTES + 16;

constexpr int PC_R = 0, PC_K = 1024, PC_V = 2048, PC_GQKV = 3072, PC_Z = 5120, PC_SMALL = 6144, PC_BRAW = 6432, PC_ARAW = 6440;

constexpr size_t MiB = 1ull << 20;
constexpr size_t WS_WGU = 0, WS_WD = 44 * MiB;
constexpr size_t WS_GDNP = 0, WS_GBETA = 64 * MiB, WS_GG = 64 * MiB + 512 * 1024;
constexpr size_t WS_WIN = 66 * MiB;
constexpr size_t WS_LIFT = 108 * MiB;
constexpr size_t WS_RWG = 116 * MiB;
constexpr size_t WS_WOUT = 116 * MiB, WS_MQ = 124 * MiB, WS_MK = 132 * MiB, WS_MV = 140 * MiB, WS_MO = 148 * MiB;
constexpr size_t WS_ACT = 156 * MiB;
constexpr size_t WS_BIG = 220 * MiB;
constexpr size_t WS_RWP = WS_BIG + 208 * MiB;
constexpr size_t WS_HQ = WS_BIG, WS_Q = WS_BIG + 64 * MiB, WS_KM = WS_BIG + 128 * MiB, WS_VT = WS_BIG + 129 * MiB, WS_MKVN = WS_BIG + 130 * MiB;
constexpr size_t WS_END = 556 * MiB;

struct Params {
    const float* in[36];
    float* out;
    unsigned char* ws;
};

typedef __bf16 bf16x2n __attribute__((ext_vector_type(2)));
__device__ __forceinline__ unsigned cvt_pk_bf16(float lo, float hi) { const bf16x2n v = __builtin_convertvector((f32x2){lo, hi}, bf16x2n); return __builtin_bit_cast(unsigned, v); }
__device__ __forceinline__ bf16_t f2bf(float f) { return (bf16_t)(cvt_pk_bf16(f, 0.f) & 0xffffu); }
__device__ __forceinline__ float bf2f(bf16_t b) { return __uint_as_float(((unsigned)b) << 16); }
__device__ __forceinline__ float bflo(unsigned u) { return __uint_as_float(u << 16); }
__device__ __forceinline__ float bfhi(unsigned u) { return __uint_as_float(u & 0xffff0000u); }
__device__ __forceinline__ float sigmoidf_(float x) { return __builtin_amdgcn_rcpf(1.f + __expf(-x)); }
__device__ __forceinline__ float siluf_(float x) { return x * __builtin_amdgcn_rcpf(1.f + __expf(-x)); }
__device__ __forceinline__ float softplusf_(float x) { return x > 20.f ? x : log1pf(__expf(x)); }
__device__ __forceinline__ float wave_sum(float v) {
#pragma unroll
    for (int o = 32; o >= 1; o >>= 1) v += __shfl_xor(v, o);
    return v;
}
template <int CTRL> __device__ __forceinline__ float dppf(float v) { return __builtin_bit_cast(float, __builtin_amdgcn_update_dpp(0, __builtin_bit_cast(int, v), CTRL, 0xF, 0xF, true)); }
__device__ __forceinline__ float red8(float v) { v += dppf<0xB1>(v); v += dppf<0x4E>(v); v += dppf<0x141>(v); return v; }
__device__ __forceinline__ float red16(float v) { v = red8(v); v += dppf<0x140>(v); return v; }

__host__ __device__ __forceinline__ int lds_byte(int r, int c) { const int st = (r >> 4) * 2 + (c >> 5), rr = r & 15, cc = c & 31, ob = rr * 64 + cc * 2; return st * 1024 + (ob ^ (((ob >> 9) & 1) << 5)); }
__host__ __device__ __forceinline__ void stage_rc(int b, int& R, int& C) { const int st = b / 1024, sb = b % 1024, swz = sb ^ (((sb >> 9) & 1) << 5); R = (st >> 1) * 16 + swz / 64; C = (st & 1) * 32 + (swz % 64) / 2; }
__host__ __device__ __forceinline__ int perm32(int rho) { const int n = rho >> 4, i = rho & 15; return 8 * (i >> 2) + 4 * n + (i & 3); }

struct Unit { int pm, pn; };
struct Gemm { const bf16_t* A; const bf16_t* Bt; int M, N, K, lda; };

struct StaticOrder {
    int nM, nN, nwg, G, c;
    __device__ void init(int M, int N, int G_, int c_) { nM = M / BM; nN = N / BM; nwg = nM * nN; G = G_; c = c_; }
    __device__ bool next(int i, Unit& u) const {
        const long L = (long)i * G + c; if (L >= nwg) return false;
        int wgid = (int)L; { const int q = nwg / NXCD, r = nwg % NXCD, xcd = wgid % NXCD, off = wgid / NXCD; wgid = (xcd < r ? xcd * (q + 1) : r * (q + 1) + (xcd - r) * q) + off; }
        const int nig = WGM * nN, gid = wgid / nig, fm = gid * WGM, gsz = (nM - fm) < WGM ? (nM - fm) : WGM;
        u.pm = fm + ((wgid % nig) % gsz); u.pn = (wgid % nig) / gsz; return true;
    }
};

template <int MODE> struct Epi {
    static constexpr bool PERM = (MODE != 1 && MODE < 7);
    void* out; int ldc; const void* aux; int ldaux; float scale;
    __device__ __forceinline__ void operator()(const f32x4 (&acc)[2][2][4][2], const Unit& u, int wr, int wc, int fr, int fq) const {
        const int row0 = u.pm * BM + wr * 64 + fr;
        if constexpr (MODE >= 7) {
            const int col0 = u.pn * BM + wc * 32 + 4 * fq;
#pragma unroll
            for (int ai = 0; ai < 2; ++ai)
#pragma unroll
                for (int m = 0; m < 4; ++m) {
                    const size_t ro = (size_t)(row0 + ai * HALF + m * 16);
#pragma unroll
                    for (int bj = 0; bj < 2; ++bj)
#pragma unroll
                        for (int n = 0; n < 2; ++n) {
                            const int cc = col0 + bj * HALF + n * 16;
                            f32x4 rv;
                            if constexpr (MODE == 8) rv = *(const f32x4*)((const float*)aux + ro * ldaux + cc);
                            else { const u32x2 ru = *(const u32x2*)((const bf16_t*)aux + ro * ldaux + cc); rv = (f32x4){bflo(ru.x), bfhi(ru.x), bflo(ru.y), bfhi(ru.y)}; }
                            const f32x4 o = rv + acc[ai][bj][m][n] * scale;
                            if constexpr (MODE == 9) *(f32x4*)((float*)out + ro * ldc + cc) = o;
                            else { u32x2 w; w.x = cvt_pk_bf16(o.x, o.y); w.y = cvt_pk_bf16(o.z, o.w); *(u32x2*)((bf16_t*)out + ro * ldc + cc) = w; }
                        }
                }
        } else if constexpr (MODE == 1) {
            const int col0 = u.pn * BM + wc * 32 + 4 * fq;
#pragma unroll
            for (int ai = 0; ai < 2; ++ai)
#pragma unroll
                for (int m = 0; m < 4; ++m) {
                    const size_t ro = (size_t)(row0 + ai * HALF + m * 16);
                    float* op = (float*)out + ro * ldc + col0; const float* rp = (const float*)aux + ro * ldaux + col0;
#pragma unroll
                    for (int bj = 0; bj < 2; ++bj)
#pragma unroll
                        for (int n = 0; n < 2; ++n) { const f32x4 rv = *(const f32x4*)(rp + bj * HALF + n * 16); *(f32x4*)(op + bj * HALF + n * 16) = rv + acc[ai][bj][m][n] * scale; }
                }
        } else if constexpr (MODE == 0) {
            const int col0 = u.pn * HALF + wc * 32 + 8 * fq;
#pragma unroll
            for (int ai = 0; ai < 2; ++ai)
#pragma unroll
                for (int m = 0; m < 4; ++m) {
                    bf16_t* op = (bf16_t*)out + (size_t)(row0 + ai * HALF + m * 16) * ldc + col0;
                    float v[8];
#pragma unroll
                    for (int n = 0; n < 2; ++n)
#pragma unroll
                        for (int i = 0; i < 4; ++i) { const float g = acc[ai][0][m][n][i], up = acc[ai][1][m][n][i]; v[n * 4 + i] = siluf_(g) * up; }
                    u32x4 w; w.x = cvt_pk_bf16(v[0], v[1]); w.y = cvt_pk_bf16(v[2], v[3]); w.z = cvt_pk_bf16(v[4], v[5]); w.w = cvt_pk_bf16(v[6], v[7]);
                    *(u32x4*)op = w;
                }
        } else {
            const int col0 = u.pn * BM + wc * 32 + 8 * fq;
#pragma unroll
            for (int ai = 0; ai < 2; ++ai)
#pragma unroll
                for (int m = 0; m < 4; ++m) {
                    const size_t ro = (size_t)(row0 + ai * HALF + m * 16);
#pragma unroll
                    for (int bj = 0; bj < 2; ++bj) {
                        bf16_t* op = (bf16_t*)out + ro * ldc + col0 + bj * HALF;
                        float v[8];
#pragma unroll
                        for (int n = 0; n < 2; ++n)
#pragma unroll
                            for (int i = 0; i < 4; ++i) v[n * 4 + i] = acc[ai][bj][m][n][i];
                        if constexpr (MODE == 3) {
#pragma unroll
                            for (int i = 0; i < 8; ++i) v[i] = sigmoidf_(v[i]);
                        }
                        if constexpr (MODE == 4 || MODE == 5) {
                            const u32x4 gw = *(const u32x4*)((const bf16_t*)aux + ro * ldaux + col0 + bj * HALF);
                            v[0] *= bflo(gw.x); v[1] *= bfhi(gw.x); v[2] *= bflo(gw.y); v[3] *= bfhi(gw.y); v[4] *= bflo(gw.z); v[5] *= bfhi(gw.z); v[6] *= bflo(gw.w); v[7] *= bfhi(gw.w);
                        }
                        if constexpr (MODE == 5) {
                            const u32x4 pw = *(const u32x4*)op;
                            v[0] += bflo(pw.x); v[1] += bfhi(pw.x); v[2] += bflo(pw.y); v[3] += bfhi(pw.y); v[4] += bflo(pw.z); v[5] += bfhi(pw.z); v[6] += bflo(pw.w); v[7] += bfhi(pw.w);
                        }
                        u32x4 w; w.x = cvt_pk_bf16(v[0], v[1]); w.y = cvt_pk_bf16(v[2], v[3]); w.z = cvt_pk_bf16(v[4], v[5]); w.w = cvt_pk_bf16(v[6], v[7]);
                        *(u32x4*)op = w;
                    }
                }
        }
    }
};

template <class EpiT>
__device__ __forceinline__ void gemm_phase(LAS unsigned char* lds, const Gemm g, const StaticOrder& S, const EpiT& E) {
    int tid_ = threadIdx.x; asm volatile("" : "+v"(tid_));
    const int tid = tid_, wid = __builtin_amdgcn_readfirstlane(tid >> 6), lane = tid & 63, wr = wid >> 2, wc = wid & 3, fr = lane & 15, fq = lane >> 4;
    const int K = g.K, nt = K / BK, lda = g.lda;
    unsigned voffA[2], voffB[2];
#pragma unroll
    for (int i = 0; i < 2; ++i) { int R, C; stage_rc(tid * 16 + i * 8192, R, C); const int Rb = EpiT::PERM ? ((R & ~31) + perm32(R & 31)) : R;
        voffA[i] = (unsigned)(R * lda + C) * 2u; voffB[i] = (unsigned)(Rb * K + C) * 2u; }
    const size_t kstep = (size_t)(BK * 2);
    const size_t hstepA = (size_t)HALF * lda * 2, hstepB = (size_t)HALF * K * 2;
    const size_t tstepA = 2 * hstepA, tstepB = 2 * hstepB;
    const unsigned ldsw = (unsigned)wid * 1024u;
    const int aoff = lds_byte(wr * 64 + fr, fq * 8), boff = lds_byte(wc * 32 + fr, fq * 8);
#define PG8_SA(b, h) (((b) * 2 + (h)) * HTB)
#define PG8_SB(b, h) ((4 + (b) * 2 + (h)) * HTB)
#define PG8_STAGE(bufoff, gbase, voff) do { _Pragma("unroll") for (int _i = 0; _i < 2; ++_i) \
        __builtin_amdgcn_global_load_lds((const unsigned*)((const char*)(gbase) + (voff)[_i]), (LAS unsigned*)(lds + (bufoff) + ldsw + _i * 8192), 16, 0, 0); } while (0)
#define PG8_LDA(dst, b, h) do { _Pragma("unroll") for (int m = 0; m < 4; ++m) _Pragma("unroll") for (int k = 0; k < 2; ++k) dst[m][k] = *(const LAS bf16x8*)(lds + PG8_SA(b, h) + aoff + m * 2048 + k * 1024); } while (0)
#define PG8_LDB(dst, b, h) do { _Pragma("unroll") for (int n = 0; n < 2; ++n) _Pragma("unroll") for (int k = 0; k < 2; ++k) dst[n][k] = *(const LAS bf16x8*)(lds + PG8_SB(b, h) + boff + n * 2048 + k * 1024); } while (0)
#define PG8_MMA(ai, bj, At, Bt) do { __builtin_amdgcn_s_setprio(1); _Pragma("unroll") for (int m = 0; m < 4; ++m) _Pragma("unroll") for (int n = 0; n < 2; ++n) _Pragma("unroll") for (int k = 0; k < 2; ++k) \
        acc[ai][bj][m][n] = __builtin_amdgcn_mfma_f32_16x16x32_bf16(Bt[n][k], At[m][k], acc[ai][bj][m][n], 0, 0, 0); __builtin_amdgcn_s_setprio(0); } while (0)
#define PG8_WAIT_V(n) asm volatile("s_waitcnt vmcnt(" #n ")" ::: "memory")
#define PG8_WAIT_L(n) asm volatile("s_waitcnt lgkmcnt(" #n ")" ::: "memory")
#define PG8_BAR __builtin_amdgcn_s_barrier()
#define PG8_SCHED __builtin_amdgcn_sched_barrier(0)
    Unit cur, nxt; int ui = 0;
    if (!S.next(0, cur)) return;
    f32x4 acc[2][2][4][2];
#pragma unroll
    for (int a = 0; a < 2; ++a)
#pragma unroll
        for (int b = 0; b < 2; ++b)
#pragma unroll
            for (int m = 0; m < 4; ++m)
#pragma unroll
                for (int n = 0; n < 2; ++n) acc[a][b][m][n] = (f32x4){0.f, 0.f, 0.f, 0.f};
    bf16x8 At[4][2], B0[2][2], B1[2][2];
    const char* cA = (const char*)g.A + (size_t)cur.pm * tstepA; const char* cB = (const char*)g.Bt + (size_t)cur.pn * tstepB;
    PG8_STAGE(PG8_SB(0, 0), cB, voffB); PG8_STAGE(PG8_SA(0, 0), cA, voffA); PG8_STAGE(PG8_SB(0, 1), cB + hstepB, voffB); PG8_STAGE(PG8_SA(0, 1), cA + hstepA, voffA);
    if (wr == 1) PG8_BAR;
    PG8_WAIT_V(4); PG8_BAR;
    PG8_STAGE(PG8_SB(1, 0), cB + kstep, voffB); PG8_STAGE(PG8_SA(1, 0), cA + kstep, voffA); PG8_STAGE(PG8_SB(1, 1), cB + hstepB + kstep, voffB);
    PG8_WAIT_V(6); PG8_BAR;
    for (;;) {
        const bool has_next = S.next(ui + 1, nxt);
        const char* nA = has_next ? (const char*)g.A + (size_t)nxt.pm * tstepA : cA; const char* nB = has_next ? (const char*)g.Bt + (size_t)nxt.pn * tstepB : cB;
        for (int t = 0; t < nt; t += 2) {
            const bool last = (t == nt - 2);
            const char* a1 = cA + (size_t)(t + 1) * kstep;
            const char* a2 = last ? nA : cA + (size_t)(t + 2) * kstep; const char* b2 = last ? nB : cB + (size_t)(t + 2) * kstep;
            const char* a3 = a2 + kstep; const char* b3 = b2 + kstep;
            PG8_LDB(B0, 0, 0); PG8_SCHED; PG8_LDA(At, 0, 0); PG8_STAGE(PG8_SA(1, 1), a1 + hstepA, voffA);
            PG8_WAIT_L(8); PG8_BAR; PG8_WAIT_L(0); PG8_MMA(0, 0, At, B0); PG8_BAR; PG8_SCHED;
            PG8_LDB(B1, 0, 1); PG8_STAGE(PG8_SB(0, 0), b2, voffB);
            PG8_BAR; PG8_WAIT_L(0); PG8_MMA(0, 1, At, B1); PG8_BAR;
            PG8_LDA(At, 0, 1); PG8_STAGE(PG8_SA(0, 0), a2, voffA);
            PG8_BAR; PG8_WAIT_L(0); PG8_MMA(1, 0, At, B0); PG8_BAR; PG8_SCHED;
            PG8_STAGE(PG8_SB(0, 1), b2 + hstepB, voffB);
            PG8_WAIT_V(6); PG8_BAR; PG8_MMA(1, 1, At, B1); PG8_BAR;
            PG8_LDB(B0, 1, 0); PG8_SCHED; PG8_LDA(At, 1, 0); PG8_STAGE(PG8_SA(0, 1), a2 + hstepA, voffA);
            PG8_WAIT_L(8); PG8_BAR; PG8_WAIT_L(0); PG8_MMA(0, 0, At, B0); PG8_BAR; PG8_SCHED;
            PG8_LDB(B1, 1, 1); PG8_STAGE(PG8_SB(1, 0), b3, voffB);
            PG8_BAR; PG8_WAIT_L(0); PG8_MMA(0, 1, At, B1); PG8_BAR;
            PG8_LDA(At, 1, 1); PG8_STAGE(PG8_SA(1, 0), a3, voffA);
            PG8_BAR; PG8_WAIT_L(0); PG8_MMA(1, 0, At, B0); PG8_BAR; PG8_SCHED;
            PG8_STAGE(PG8_SB(1, 1), b3 + hstepB, voffB);
            PG8_WAIT_V(6); PG8_BAR; PG8_MMA(1, 1, At, B1); PG8_BAR;
        }
        E(acc, cur, wr, wc, fr, fq);
        if (!has_next) break;
#pragma unroll
        for (int a = 0; a < 2; ++a)
#pragma unroll
            for (int b = 0; b < 2; ++b)
#pragma unroll
                for (int m = 0; m < 4; ++m)
#pragma unroll
                    for (int n = 0; n < 2; ++n) acc[a][b][m][n] = (f32x4){0.f, 0.f, 0.f, 0.f};
        cur = nxt; cA = nA; cB = nB; ++ui;
    }
    PG8_WAIT_V(0);
    if (wr == 0) PG8_BAR;
    PG8_BAR;
#undef PG8_SA
#undef PG8_SB
#undef PG8_STAGE
#undef PG8_LDA
#undef PG8_LDB
#undef PG8_MMA
#undef PG8_WAIT_V
#undef PG8_WAIT_L
#undef PG8_BAR
#undef PG8_SCHED
}

template <int MODE>
__device__ __forceinline__ void run_gemm(LAS unsigned char* lds, const bf16_t* A, int lda, const bf16_t* Bt, int M, int N, int K, void* out, int ldc, const void* aux, int ldaux, float scale, int cshift) {
    Gemm g; g.A = A; g.Bt = Bt; g.M = M; g.N = N; g.K = K; g.lda = lda;
    StaticOrder S; S.init(M, N, (int)gridDim.x, (int)((blockIdx.x + cshift) % gridDim.x));
    Epi<MODE> E; E.out = out; E.ldc = ldc; E.aux = aux; E.ldaux = ldaux; E.scale = scale;
    gemm_phase(lds, g, S, E);
}

__device__ __forceinline__ int win_map(int n) {
    if (n < 3072) return n;
    if (n < 5120) return 3360 + (n - 3072);
    if (n < 6144) return 3360 + 2048 + (n - 5120);
    if (n < 6432) return 3072 + (n - 6144);
    if (n < 6448) return 3360 + 3072 + (n - 6432);
    if (n < 6656) return -1;
    return 6448 + (n - 6656);
}
__device__ __forceinline__ void convert_w(unsigned char* lds_, const float* src, const float* src2, const float* gain, bf16_t* dst, int K, int N, int ld, int kind, int wg, int nwg) {
    constexpr int KT = 256, LP = KT + 8;
    bf16_t* tl = (bf16_t*)lds_;
    const int tid = threadIdx.x;
    const int nnb = N / 64, nkb = K / KT, ntl = nnb * nkb;
    for (int tile = wg; tile < ntl; tile += nwg) {
        const int nb = tile % nnb, kb = tile / nnb;
        const int nl = tid & 63, n = nb * 64 + nl;
        const float* sp = src; int col = n;
        if (kind == 1) { const int pn = n >> 8, w = n & 255; sp = (w < 128) ? src : src2; col = pn * 128 + (w & 127); }
        else if (kind == 2) col = win_map(n);
        float v[32];
        const float* bp = sp + (size_t)(kb * KT + (tid >> 6)) * ld + (col >= 0 ? col : 0);
#pragma unroll
        for (int p = 0; p < 32; ++p) v[p] = bp[(size_t)(8 * p) * ld];
        if (col < 0) {
#pragma unroll
            for (int p = 0; p < 32; ++p) v[p] = 0.f;
        }
        if (gain) {
#pragma unroll
            for (int p = 0; p < 32; ++p) v[p] *= gain[kb * KT + (tid >> 6) + 8 * p];
        }
#pragma unroll
        for (int p = 0; p < 32; ++p) tl[nl * LP + (tid >> 6) + 8 * p] = f2bf(v[p]);
        __syncthreads();
        { const int nr = tid >> 3, kq = (tid & 7) * 8;
#pragma unroll
          for (int i = 0; i < 4; ++i) {
            const u32x4 w = *(const u32x4*)(tl + nr * LP + kq + 64 * i);
            *(u32x4*)(dst + (size_t)(nb * 64 + nr) * K + kb * KT + kq + 64 * i) = w; } }
        __syncthreads();
    }
}

#define UNPK8N(dst, u) do { dst[0] = bflo(u.x); dst[1] = bfhi(u.x); dst[2] = bflo(u.y); dst[3] = bfhi(u.y); dst[4] = bflo(u.z); dst[5] = bfhi(u.z); dst[6] = bflo(u.w); dst[7] = bfhi(u.w); } while (0)
__device__ __forceinline__ void rownorm_bf16(const float* src, bf16_t* dst, int rows, int wg, int nwg) {
    const int lane = threadIdx.x & 63, wid = threadIdx.x >> 6;
    for (int row = wg * 8 + wid; row < rows; row += nwg * 8) {
        const f32x4* p = (const f32x4*)(src + (size_t)row * D);
        f32x4 v[8]; float ss = 0.f;
#pragma unroll
        for (int i = 0; i < 8; ++i) { v[i] = p[lane + 64 * i]; ss += v[i].x * v[i].x + v[i].y * v[i].y + v[i].z * v[i].z + v[i].w * v[i].w; }
        ss = wave_sum(ss);
        const float rs = rsqrtf(ss * (1.f / D) + 1e-6f);
#pragma unroll
        for (int i = 0; i < 8; ++i) { u32x2 w; w.x = cvt_pk_bf16(v[i].x * rs, v[i].y * rs); w.y = cvt_pk_bf16(v[i].z * rs, v[i].w * rs); *(u32x2*)(dst + (size_t)row * D + (lane + 64 * i) * 4) = w; }
    }
}
__device__ __forceinline__ void rownorm_b2b(const bf16_t* src, bf16_t* dst, int rows, int wg, int nwg) {
    const int lane = threadIdx.x & 63, wid = threadIdx.x >> 6;
    for (int row = wg * 8 + wid; row < rows; row += nwg * 8) {
        const u32x4* p = (const u32x4*)(src + (size_t)row * D);
        float v[4][8]; float ss = 0.f;
#pragma unroll
        for (int i = 0; i < 4; ++i) { const u32x4 u = p[lane + 64 * i]; UNPK8N(v[i], u);
#pragma unroll
            for (int e = 0; e < 8; ++e) ss += v[i][e] * v[i][e]; }
        ss = wave_sum(ss);
        const float rs = rsqrtf(ss * (1.f / D) + 1e-6f);
#pragma unroll
        for (int i = 0; i < 4; ++i) { u32x4 w; w.x = cvt_pk_bf16(v[i][0] * rs, v[i][1] * rs); w.y = cvt_pk_bf16(v[i][2] * rs, v[i][3] * rs); w.z = cvt_pk_bf16(v[i][4] * rs, v[i][5] * rs); w.w = cvt_pk_bf16(v[i][6] * rs, v[i][7] * rs);
            *(u32x4*)(dst + (size_t)row * D + (lane + 64 * i) * 8) = w; }
    }
}
__device__ __forceinline__ void rownorm_xd(const float* xsrc, const bf16_t* dsrc, float dscale, bf16_t* hdst, bf16_t* udst, int rows, int wg, int nwg) {
    const int lane = threadIdx.x & 63, wid = threadIdx.x >> 6;
    for (int row = wg * 8 + wid; row < rows; row += nwg * 8) {
        const f32x4* px = (const f32x4*)(xsrc + (size_t)row * D); const u32x4* pd = (const u32x4*)(dsrc + (size_t)row * D);
        float v[4][8]; float ss = 0.f;
#pragma unroll
        for (int i = 0; i < 4; ++i) { const f32x4 a = px[(lane + 64 * i) * 2], b = px[(lane + 64 * i) * 2 + 1]; const u32x4 dd = pd[lane + 64 * i]; float y[8]; UNPK8N(y, dd);
            v[i][0] = a.x + dscale * y[0]; v[i][1] = a.y + dscale * y[1]; v[i][2] = a.z + dscale * y[2]; v[i][3] = a.w + dscale * y[3];
            v[i][4] = b.x + dscale * y[4]; v[i][5] = b.y + dscale * y[5]; v[i][6] = b.z + dscale * y[6]; v[i][7] = b.w + dscale * y[7];
#pragma unroll
            for (int e = 0; e < 8; ++e) ss += v[i][e] * v[i][e]; }
        ss = wave_sum(ss);
        const float rs = rsqrtf(ss * (1.f / D) + 1e-6f);
#pragma unroll
        for (int i = 0; i < 4; ++i) {
            u32x4 w; w.x = cvt_pk_bf16(v[i][0], v[i][1]); w.y = cvt_pk_bf16(v[i][2], v[i][3]); w.z = cvt_pk_bf16(v[i][4], v[i][5]); w.w = cvt_pk_bf16(v[i][6], v[i][7]);
            *(u32x4*)(hdst + (size_t)row * D + (lane + 64 * i) * 8) = w;
            u32x4 z; z.x = cvt_pk_bf16(v[i][0] * rs, v[i][1] * rs); z.y = cvt_pk_bf16(v[i][2] * rs, v[i][3] * rs); z.z = cvt_pk_bf16(v[i][4] * rs, v[i][5] * rs); z.w = cvt_pk_bf16(v[i][6] * rs, v[i][7] * rs);
            *(u32x4*)(udst + (size_t)row * D + (lane + 64 * i) * 8) = z;
        }
    }
}
__device__ __forceinline__ void merge_pass(const bf16_t* gates, bf16_t* la, const bf16_t* lb, int wg, int nwg) {
    for (size_t it = (size_t)wg * 512 + threadIdx.x; it < (size_t)T * (D / 8); it += (size_t)nwg * 512) {
        const size_t t = it / (D / 8); const int c8 = (int)(it % (D / 8)) * 8;
        const u32x4 ga = *(const u32x4*)(gates + t * (2 * D) + c8), gb = *(const u32x4*)(gates + t * (2 * D) + D + c8);
        const u32x4 ua = *(const u32x4*)(la + t * D + c8), ub = *(const u32x4*)(lb + t * D + c8);
        float a[8], b[8], x[8], y[8]; UNPK8N(a, ga); UNPK8N(b, gb); UNPK8N(x, ua); UNPK8N(y, ub);
        float m[8];
#pragma unroll
        for (int e = 0; e < 8; ++e) m[e] = a[e] * x[e] + b[e] * y[e];
        u32x4 w; w.x = cvt_pk_bf16(m[0], m[1]); w.y = cvt_pk_bf16(m[2], m[3]); w.z = cvt_pk_bf16(m[4], m[5]); w.w = cvt_pk_bf16(m[6], m[7]);
        *(u32x4*)(la + t * D + c8) = w;
    }
}
__device__ __forceinline__ void rownorm_bd(const bf16_t* hsrc, const bf16_t* dsrc, bf16_t* hdst, bf16_t* udst, int rows, int wg, int nwg) {
    const int lane = threadIdx.x & 63, wid = threadIdx.x >> 6;
    for (int row = wg * 8 + wid; row < rows; row += nwg * 8) {
        const u32x4* ph = (const u32x4*)(hsrc + (size_t)row * D); const u32x4* pd = (const u32x4*)(dsrc + (size_t)row * D);
        float v[4][8]; float ss = 0.f;
#pragma unroll
        for (int i = 0; i < 4; ++i) { const u32x4 a = ph[lane + 64 * i], b = pd[lane + 64 * i]; float x[8], y[8]; UNPK8N(x, a); UNPK8N(y, b);
#pragma unroll
            for (int e = 0; e < 8; ++e) { v[i][e] = x[e] + y[e]; ss += v[i][e] * v[i][e]; } }
        ss = wave_sum(ss);
        const float rs = rsqrtf(ss * (1.f / D) + 1e-6f);
#pragma unroll
        for (int i = 0; i < 4; ++i) {
            u32x4 w; w.x = cvt_pk_bf16(v[i][0], v[i][1]); w.y = cvt_pk_bf16(v[i][2], v[i][3]); w.z = cvt_pk_bf16(v[i][4], v[i][5]); w.w = cvt_pk_bf16(v[i][6], v[i][7]);
            *(u32x4*)(hdst + (size_t)row * D + (lane + 64 * i) * 8) = w;
            u32x4 z; z.x = cvt_pk_bf16(v[i][0] * rs, v[i][1] * rs); z.y = cvt_pk_bf16(v[i][2] * rs, v[i][3] * rs); z.z = cvt_pk_bf16(v[i][4] * rs, v[i][5] * rs); z.w = cvt_pk_bf16(v[i][6] * rs, v[i][7] * rs);
            *(u32x4*)(udst + (size_t)row * D + (lane + 64 * i) * 8) = z;
        }
    }
}
__device__ __forceinline__ void final_norm3(const bf16_t* hsrc, const bf16_t* dsrc, float dscale, float* dst, const float* gain, int rows, int wg, int nwg) {
    const int lane = threadIdx.x & 63, wid = threadIdx.x >> 6;
    for (int row = wg * 8 + wid; row < rows; row += nwg * 8) {
        const u32x4* ph = (const u32x4*)(hsrc + (size_t)row * D); const u32x4* pd = (const u32x4*)(dsrc + (size_t)row * D);
        float v[4][8]; float ss = 0.f;
#pragma unroll
        for (int i = 0; i < 4; ++i) { const u32x4 a = ph[lane + 64 * i], b = pd[lane + 64 * i]; float x[8], y[8]; UNPK8N(x, a); UNPK8N(y, b);
#pragma unroll
            for (int e = 0; e < 8; ++e) { v[i][e] = x[e] + dscale * y[e]; ss += v[i][e] * v[i][e]; } }
        ss = wave_sum(ss);
        const float rs = rsqrtf(ss * (1.f / D) + 1e-6f);
#pragma unroll
        for (int i = 0; i < 4; ++i) {
            const f32x4 g0 = ((const f32x4*)gain)[(lane + 64 * i) * 2], g1 = ((const f32x4*)gain)[(lane + 64 * i) * 2 + 1];
            f32x4* q = (f32x4*)(dst + (size_t)row * D + (lane + 64 * i) * 8);
            q[0] = (f32x4){v[i][0], v[i][1], v[i][2], v[i][3]} * rs * g0; q[1] = (f32x4){v[i][4], v[i][5], v[i][6], v[i][7]} * rs * g1;
        }
    }
}
__device__ __forceinline__ void final_norm2(const float* src, float* dst, const float* gain, int rows, int wg, int nwg) {
    const int lane = threadIdx.x & 63, wid = threadIdx.x >> 6;
    for (int row = wg * 8 + wid; row < rows; row += nwg * 8) {
        const f32x4* p = (const f32x4*)(src + (size_t)row * D); f32x4* q = (f32x4*)(dst + (size_t)row * D);
        f32x4 v[8]; float ss = 0.f;
#pragma unroll
        for (int i = 0; i < 8; ++i) { v[i] = p[lane + 64 * i]; ss += v[i].x * v[i].x + v[i].y * v[i].y + v[i].z * v[i].z + v[i].w * v[i].w; }
        ss = wave_sum(ss);
        const float rs = rsqrtf(ss * (1.f / D) + 1e-6f);
#pragma unroll
        for (int i = 0; i < 8; ++i) { const f32x4 gv = ((const f32x4*)gain)[lane + 64 * i]; q[lane + 64 * i] = v[i] * rs * gv; }
    }
}
__device__ __forceinline__ void final_norm(float* io, const float* gain, int rows, int wg, int nwg) {
    const int lane = threadIdx.x & 63, wid = threadIdx.x >> 6;
    for (int row = wg * 8 + wid; row < rows; row += nwg * 8) {
        f32x4* p = (f32x4*)(io + (size_t)row * D);
        f32x4 v[8]; float ss = 0.f;
#pragma unroll
        for (int i = 0; i < 8; ++i) { v[i] = p[lane + 64 * i]; ss += v[i].x * v[i].x + v[i].y * v[i].y + v[i].z * v[i].z + v[i].w * v[i].w; }
        ss = wave_sum(ss);
        const float rs = rsqrtf(ss * (1.f / D) + 1e-6f);
#pragma unroll
        for (int i = 0; i < 8; ++i) { const f32x4 gv = ((const f32x4*)gain)[lane + 64 * i]; p[lane + 64 * i] = v[i] * rs * gv; }
    }
}

constexpr size_t WS_LORA = 148 * MiB;
__device__ __forceinline__ void lora_frags(const Params& P, int wg, int nwg) {
    bf16_t* dst = (bf16_t*)(P.ws + WS_LORA);
    for (int idx = wg * 512 + threadIdx.x; idx < 64 * 9 * 64; idx += nwg * 512) {
        const int lane = idx & 63, frag = idx >> 6, cg = frag / 9, f = frag - cg * 9, r = lane & 15, qd = lane >> 4;
        const float* W = f < 2 ? P.in[10] : (f < 4 ? P.in[12] : P.in[13]);
        const int ks = f < 2 ? f : (f < 4 ? f - 2 : f - 4);
        float v[8];
#pragma unroll
        for (int j = 0; j < 8; ++j) v[j] = W[(size_t)(32 * ks + 8 * qd + j) * 1024 + 16 * cg + r];
        u32x4 w; w.x = cvt_pk_bf16(v[0], v[1]); w.y = cvt_pk_bf16(v[2], v[3]); w.z = cvt_pk_bf16(v[4], v[5]); w.w = cvt_pk_bf16(v[6], v[7]);
        *(u32x4*)(dst + (size_t)idx * 8) = w;
    }
}
__device__ __forceinline__ void rwkv_prep(const Params& P, unsigned char* lds_, int wg, int nwg) {
    constexpr int SP = 296;
    bf16_t* sm = (bf16_t*)lds_;
    u32x4* Bl = (u32x4*)(lds_ + 38912);
    const bf16_t* proj = (const bf16_t*)(P.ws + WS_BIG);
    const u32x4* frg = (const u32x4*)(P.ws + WS_LORA);
    bf16_t* o_ld = (bf16_t*)(P.ws + WS_RWP); bf16_t* o_kp = o_ld + (size_t)T * 1024; bf16_t* o_kk = o_kp + (size_t)T * 1024; bf16_t* o_aa = o_kk + (size_t)T * 1024;
    bf16_t* o_g = (bf16_t*)(P.ws + WS_RWG);
    const float* mu = P.in[8]; const float* w0 = P.in[9]; const float* a0 = P.in[11]; const float* k_k = P.in[14]; const float* k_a = P.in[15];
    const int tid = threadIdx.x, lane = tid & 63, wid = tid >> 6, r = lane & 15, qd = lane >> 4;
    const int tq = wid & 3, hsel = wid >> 2;
    for (int tile = wg; tile < T / 64; tile += nwg) {
        const int t0 = tile * 64;
        __syncthreads();
#pragma unroll 4
        for (int e9 = 0; e9 < 36; ++e9) {
            const int e = tid + e9 * 512;
            const int tt = e / 288, i = e - tt * 288, t = t0 + tt, col = PC_SMALL + i;
            const float cur = bf2f(proj[(size_t)t * PLD + col]); const float prev = t > 0 ? bf2f(proj[(size_t)(t - 1) * PLD + col]) : 0.f;
            float x = cur + (prev - cur) * mu[3072 + i];
            if (i < 64) x = tanhf(x); else if (i >= 128) x = sigmoidf_(x);
            sm[tt * SP + i] = f2bf(x);
        }
        __syncthreads();
        bf16x8 af[9];
#pragma unroll
        for (int f = 0; f < 9; ++f) af[f] = *(const bf16x8*)(sm + (tq * 16 + r) * SP + 32 * f + 8 * qd);
#pragma unroll 1
        for (int hp = 0; hp < 8; ++hp) {
            __syncthreads();
#pragma unroll
            for (int i = 0; i < 9; ++i) Bl[tid + 512 * i] = frg[(size_t)hp * 72 * 64 + tid + 512 * i];
            __syncthreads();
            const int head = hp * 2 + hsel;
            f32x4 aw[4], aa_[4], ag[4];
#pragma unroll
            for (int g4 = 0; g4 < 4; ++g4) {
                const u32x4* fp = Bl + ((hsel * 4 + g4) * 9) * 64 + lane;
                aw[g4] = (f32x4){0.f, 0.f, 0.f, 0.f}; aa_[g4] = aw[g4]; ag[g4] = aw[g4];
#pragma unroll
                for (int f = 0; f < 2; ++f) aw[g4] = __builtin_amdgcn_mfma_f32_16x16x32_bf16(__builtin_bit_cast(bf16x8, fp[f * 64]), af[f], aw[g4], 0, 0, 0);
#pragma unroll
                for (int f = 2; f < 4; ++f) aa_[g4] = __builtin_amdgcn_mfma_f32_16x16x32_bf16(__builtin_bit_cast(bf16x8, fp[f * 64]), af[f], aa_[g4], 0, 0, 0);
#pragma unroll
                for (int f = 4; f < 9; ++f) ag[g4] = __builtin_amdgcn_mfma_f32_16x16x32_bf16(__builtin_bit_cast(bf16x8, fp[f * 64]), af[f], ag[g4], 0, 0, 0);
            }
            const int t = t0 + tq * 16 + r;
            f32x4 kr[4], kv[4], av[4]; float ss = 0.f;
#pragma unroll
            for (int g4 = 0; g4 < 4; ++g4) {
                const int c = head * 64 + g4 * 16 + 4 * qd;
                const f32x4 muk = *(const f32x4*)(mu + 1024 + c), w0c = *(const f32x4*)(w0 + c), a0c = *(const f32x4*)(a0 + c), kkc = *(const f32x4*)(k_k + c);
                const u32x2 kcu = *(const u32x2*)(proj + (size_t)t * PLD + PC_K + c);
                u32x2 kpu = {0u, 0u}; if (t > 0) kpu = *(const u32x2*)(proj + (size_t)(t - 1) * PLD + PC_K + c);
                const f32x4 kcur = {bflo(kcu.x), bfhi(kcu.x), bflo(kcu.y), bfhi(kcu.y)}, kprev = {bflo(kpu.x), bfhi(kpu.x), bflo(kpu.y), bfhi(kpu.y)};
                const f32x4 k = kcur + (kprev - kcur) * muk;
                f32x4 ld, a;
#pragma unroll
                for (int jj = 0; jj < 4; ++jj) { ld[jj] = -0.6065306597126334f * sigmoidf_(w0c[jj] + aw[g4][jj]); a[jj] = sigmoidf_(a0c[jj] + aa_[g4][jj]); }
                kv[g4] = k; av[g4] = a; kr[g4] = k * kkc; ss += kr[g4].x * kr[g4].x + kr[g4].y * kr[g4].y + kr[g4].z * kr[g4].z + kr[g4].w * kr[g4].w;
                const size_t o = (size_t)t * 1024 + c;
                u32x2 w;
                w.x = cvt_pk_bf16(ld.x, ld.y); w.y = cvt_pk_bf16(ld.z, ld.w); *(u32x2*)(o_ld + o) = w;
                w.x = cvt_pk_bf16(a.x, a.y); w.y = cvt_pk_bf16(a.z, a.w); *(u32x2*)(o_aa + o) = w;
                w.x = cvt_pk_bf16(ag[g4].x, ag[g4].y); w.y = cvt_pk_bf16(ag[g4].z, ag[g4].w); *(u32x2*)(o_g + o) = w;
            }
            ss += __shfl_xor(ss, 16); ss += __shfl_xor(ss, 32);
            const float rn = rsqrtf(ss + 1e-6f);
#pragma unroll
            for (int g4 = 0; g4 < 4; ++g4) {
                const int c = head * 64 + g4 * 16 + 4 * qd; const f32x4 kac = *(const f32x4*)(k_a + c);
                const f32x4 kk = kr[g4] * rn, kp = kv[g4] * ((av[g4] - 1.f) * kac + 1.f);
                const size_t o = (size_t)t * 1024 + c;
                u32x2 w;
                w.x = cvt_pk_bf16(kk.x, kk.y); w.y = cvt_pk_bf16(kk.z, kk.w); *(u32x2*)(o_kk + o) = w;
                w.x = cvt_pk_bf16(kp.x, kp.y); w.y = cvt_pk_bf16(kp.z, kp.w); *(u32x2*)(o_kp + o) = w;
            }
        }
    }
}

__device__ __forceinline__ void gdn_prep(const Params& P, int wg, int nwg) {
    const bf16_t* proj = (const bf16_t*)(P.ws + WS_BIG);
    bf16_t* gp = (bf16_t*)(P.ws + WS_GDNP); float* gbeta = (float*)(P.ws + WS_GBETA); float* gg = (float*)(P.ws + WS_GG);
    const float* cw = P.in[19]; const float* a_log = P.in[20]; const float* dt_bias = P.in[21];
    const int tid = threadIdx.x;
    for (int tile = wg; tile < T / 64; tile += nwg) {
        const int t0 = tile * 64;
        const int ca = 2 * tid, cb = 1024 + 2 * tid;
        float w[4][4];
#pragma unroll
        for (int i = 0; i < 4; ++i) { w[0][i] = cw[i * 2048 + ca]; w[1][i] = cw[i * 2048 + ca + 1]; w[2][i] = cw[i * 2048 + cb]; w[3][i] = cw[i * 2048 + cb + 1]; }
        float x[4][4];
#pragma unroll
        for (int h = 0; h < 3; ++h) {
            const int t = t0 - 3 + h;
            unsigned ua = 0, ub = 0;
            if (t >= 0) { ua = *(const unsigned*)(proj + (size_t)t * PLD + PC_GQKV + ca); ub = *(const unsigned*)(proj + (size_t)t * PLD + PC_GQKV + cb); }
            x[0][h + 1] = bflo(ua); x[1][h + 1] = bfhi(ua); x[2][h + 1] = bflo(ub); x[3][h + 1] = bfhi(ub);
        }
        const float qscale = (tid < 256) ? 0.08838834764831845f : 1.f;
        for (int tb = 0; tb < 64; tb += 8) {
            unsigned ua[8], ub[8];
#pragma unroll
            for (int i = 0; i < 8; ++i) { const size_t ro = (size_t)(t0 + tb + i) * PLD + PC_GQKV; ua[i] = *(const unsigned*)(proj + ro + ca); ub[i] = *(const unsigned*)(proj + ro + cb); }
#pragma unroll
            for (int i = 0; i < 8; ++i) {
                const int t = t0 + tb + i;
#pragma unroll
                for (int c = 0; c < 4; ++c) { x[c][0] = x[c][1]; x[c][1] = x[c][2]; x[c][2] = x[c][3]; }
                x[0][3] = bflo(ua[i]); x[1][3] = bfhi(ua[i]); x[2][3] = bflo(ub[i]); x[3][3] = bfhi(ub[i]);
                float y[4];
#pragma unroll
                for (int c = 0; c < 4; ++c) { const float sacc = w[c][0] * x[c][0] + w[c][1] * x[c][1] + w[c][2] * x[c][2] + w[c][3] * x[c][3]; y[c] = siluf_(sacc); }
                const float ss = wave_sum(y[0] * y[0] + y[1] * y[1]);
                const float rs = rsqrtf(ss + 1e-6f) * qscale;
                *(unsigned*)(gp + (size_t)t * 2048 + ca) = cvt_pk_bf16(y[0] * rs, y[1] * rs);
                *(unsigned*)(gp + (size_t)t * 2048 + cb) = cvt_pk_bf16(y[2], y[3]);
            }
        }
        if (tid < 64) {
            for (int e = tid; e < 64 * 8; e += 64) {
                const int tt = e >> 3, h = e & 7, t = t0 + tt;
                const float br = bf2f(proj[(size_t)t * PLD + PC_BRAW + h]), ar = bf2f(proj[(size_t)t * PLD + PC_ARAW + h]);
                gbeta[t * 8 + h] = sigmoidf_(br);
                gg[t * 8 + h] = -__expf(a_log[h]) * softplusf_(ar + dt_bias[h]);
            }
        }
    }
}

constexpr int NSEG = 64, SEGLEN = T / NSEG, TBK = 8;
constexpr size_t WS_RT = WS_WIN, WS_RL = 556 * MiB, WS_GT = WS_ACT, WS_GL = WS_ACT + 32 * MiB;
constexpr size_t WS_BAR = 572 * MiB;
constexpr size_t WS_END2 = 573 * MiB;
constexpr int WAVE_LDS = 12288;

#define UNPK8(dst, u) do { dst[0] = bflo(u.x); dst[1] = bfhi(u.x); dst[2] = bflo(u.y); dst[3] = bfhi(u.y); dst[4] = bflo(u.z); dst[5] = bfhi(u.z); dst[6] = bflo(u.w); dst[7] = bfhi(u.w); } while (0)

template <int MODE, int RI>
__device__ __forceinline__ void rwkv_job(const Params& P, float* lw, int head, int seg, int half) {
    float* sr = lw; float* sw = lw + 512; float* sk = lw + 1024; float* sv = lw + 1536; float* sna = lw + 2048; float* sb = lw + 2560;
    bf16_t* proj = (bf16_t*)(P.ws + WS_BIG);
    const bf16_t* i_ld = (const bf16_t*)(P.ws + WS_RWP); const bf16_t* i_kp = i_ld + (size_t)T * 1024; const bf16_t* i_kk = i_kp + (size_t)T * 1024; const bf16_t* i_aa = i_kk + (size_t)T * 1024;
    const float* mu = P.in[8];
    const int lane = threadIdx.x & 63, jg = lane & 7, ig = lane >> 3;
    const int ltt = lane >> 3, lc8 = (lane & 7) * 8, ch = head * 64 + lc8;
    const int row0 = (RI == 8) ? ig * 8 : half * 32 + ig * 4;
    f32x2 S[RI][4];
    if constexpr (MODE == 2) {
        const float* sp = (const float*)(P.ws + WS_RL) + ((size_t)(head * NSEG + seg) * 64 + row0) * 64 + jg * 8;
#pragma unroll
        for (int ri = 0; ri < RI; ++ri) { const f32x4 a = *(const f32x4*)(sp + ri * 64), b = *(const f32x4*)(sp + ri * 64 + 4); S[ri][0] = (f32x2){a.x, a.y}; S[ri][1] = (f32x2){a.z, a.w}; S[ri][2] = (f32x2){b.x, b.y}; S[ri][3] = (f32x2){b.z, b.w}; }
    } else {
#pragma unroll
        for (int ri = 0; ri < RI; ++ri)
#pragma unroll
            for (int jj = 0; jj < 4; ++jj) { S[ri][jj] = (f32x2){0.f, 0.f}; if (MODE == 0) { if (row0 + ri == jg * 8 + 2 * jj) S[ri][jj].x = 1.f; if (row0 + ri == jg * 8 + 2 * jj + 1) S[ri][jj].y = 1.f; } }
    }
    u32x4 g_rc, g_rp, g_vc, g_vp, g_ld, g_kp, g_kk, g_aa;
    const int tbase = seg * SEGLEN;
    auto issue = [&](int blk) {
        const int t = tbase + blk * TBK + ltt;
        const size_t o = (size_t)t * 1024 + ch;
        g_ld = *(const u32x4*)(i_ld + o); g_kk = *(const u32x4*)(i_kk + o); g_aa = *(const u32x4*)(i_aa + o);
        if (MODE != 0) {
            g_kp = *(const u32x4*)(i_kp + o);
            g_vc = *(const u32x4*)(proj + (size_t)t * PLD + PC_V + ch);
            if (t > 0) g_vp = *(const u32x4*)(proj + (size_t)(t - 1) * PLD + PC_V + ch); else g_vp = (u32x4){0u, 0u, 0u, 0u};
        }
        if (MODE == 2) {
            g_rc = *(const u32x4*)(proj + (size_t)t * PLD + PC_R + ch);
            if (t > 0) g_rp = *(const u32x4*)(proj + (size_t)(t - 1) * PLD + PC_R + ch); else g_rp = (u32x4){0u, 0u, 0u, 0u};
        }
    };
    issue(0);
    for (int blk = 0; blk < SEGLEN / TBK; ++blk) {
        {
            float ld[8], kk[8], aa[8];
            UNPK8(ld, g_ld); UNPK8(kk, g_kk); UNPK8(aa, g_aa);
            const int o = ltt * 64 + lc8;
#pragma unroll
            for (int e = 0; e < 8; ++e) { sw[o + e] = __expf(ld[e]); sna[o + e] = -kk[e]; sb[o + e] = kk[e] * aa[e]; }
            if (MODE != 0) {
                float kp[8], vc[8], vp[8];
                UNPK8(kp, g_kp); UNPK8(vc, g_vc); UNPK8(vp, g_vp);
#pragma unroll
                for (int e = 0; e < 8; ++e) { sk[o + e] = kp[e]; sv[o + e] = vc[e] + (vp[e] - vc[e]) * mu[2048 + ch + e]; }
            }
            if (MODE == 2) {
                float rc[8], rp[8];
                UNPK8(rc, g_rc); UNPK8(rp, g_rp);
#pragma unroll
                for (int e = 0; e < 8; ++e) sr[o + e] = rc[e] + (rp[e] - rc[e]) * mu[ch + e];
            }
        }
        if (blk + 1 < SEGLEN / TBK) issue(blk + 1);
#pragma unroll 2
        for (int s = 0; s < TBK; ++s) {
            f32x2 w[4], k[4], na[4], b[4], r[4]; float v[8];
            { const f32x4 x0 = *(const f32x4*)(sw + s * 64 + jg * 8), x1 = *(const f32x4*)(sw + s * 64 + jg * 8 + 4); w[0] = (f32x2){x0.x, x0.y}; w[1] = (f32x2){x0.z, x0.w}; w[2] = (f32x2){x1.x, x1.y}; w[3] = (f32x2){x1.z, x1.w}; }
            { const f32x4 x0 = *(const f32x4*)(sna + s * 64 + jg * 8), x1 = *(const f32x4*)(sna + s * 64 + jg * 8 + 4); na[0] = (f32x2){x0.x, x0.y}; na[1] = (f32x2){x0.z, x0.w}; na[2] = (f32x2){x1.x, x1.y}; na[3] = (f32x2){x1.z, x1.w}; }
            { const f32x4 x0 = *(const f32x4*)(sb + s * 64 + jg * 8), x1 = *(const f32x4*)(sb + s * 64 + jg * 8 + 4); b[0] = (f32x2){x0.x, x0.y}; b[1] = (f32x2){x0.z, x0.w}; b[2] = (f32x2){x1.x, x1.y}; b[3] = (f32x2){x1.z, x1.w}; }
            if (MODE != 0) {
                const f32x4 x0 = *(const f32x4*)(sk + s * 64 + jg * 8), x1 = *(const f32x4*)(sk + s * 64 + jg * 8 + 4); k[0] = (f32x2){x0.x, x0.y}; k[1] = (f32x2){x0.z, x0.w}; k[2] = (f32x2){x1.x, x1.y}; k[3] = (f32x2){x1.z, x1.w};
                const f32x4 v0 = *(const f32x4*)(sv + s * 64 + row0); v[0] = v0.x; v[1] = v0.y; v[2] = v0.z; v[3] = v0.w;
                if (RI == 8) { const f32x4 v1 = *(const f32x4*)(sv + s * 64 + row0 + 4); v[4] = v1.x; v[5] = v1.y; v[6] = v1.z; v[7] = v1.w; }
            }
            if (MODE == 2) { const f32x4 x0 = *(const f32x4*)(sr + s * 64 + jg * 8), x1 = *(const f32x4*)(sr + s * 64 + jg * 8 + 4); r[0] = (f32x2){x0.x, x0.y}; r[1] = (f32x2){x0.z, x0.w}; r[2] = (f32x2){x1.x, x1.y}; r[3] = (f32x2){x1.z, x1.w}; }
            float yk = 0.f;
            float sa[RI];
#pragma unroll
            for (int ri = 0; ri < RI; ++ri) {
                f32x2 a2 = S[ri][0] * na[0], a3 = S[ri][1] * na[1];
                a2 += S[ri][2] * na[2]; a3 += S[ri][3] * na[3]; a2 += a3;
                sa[ri] = a2.x + a2.y;
            }
#pragma unroll
            for (int ri = 0; ri < RI; ++ri) sa[ri] += dppf<0xB1>(sa[ri]);
#pragma unroll
            for (int ri = 0; ri < RI; ++ri) sa[ri] += dppf<0x4E>(sa[ri]);
#pragma unroll
            for (int ri = 0; ri < RI; ++ri) sa[ri] += dppf<0x141>(sa[ri]);
#pragma unroll
            for (int ri = 0; ri < RI; ++ri) {
#pragma unroll
                for (int jj = 0; jj < 4; ++jj) { f32x2 tmp = b[jj] * sa[ri]; if (MODE != 0) tmp += k[jj] * v[ri]; S[ri][jj] = S[ri][jj] * w[jj] + tmp; }
            }
            if (MODE == 2) {
                float ys[RI];
#pragma unroll
                for (int ri = 0; ri < RI; ++ri) {
                    f32x2 y2 = S[ri][0] * r[0], y3 = S[ri][1] * r[1];
                    y2 += S[ri][2] * r[2]; y3 += S[ri][3] * r[3]; y2 += y3;
                    ys[ri] = y2.x + y2.y;
                }
#pragma unroll
                for (int ri = 0; ri < RI; ++ri) ys[ri] += dppf<0xB1>(ys[ri]);
#pragma unroll
                for (int ri = 0; ri < RI; ++ri) ys[ri] += dppf<0x4E>(ys[ri]);
#pragma unroll
                for (int ri = 0; ri < RI; ++ri) ys[ri] += dppf<0x141>(ys[ri]);
#pragma unroll
                for (int ri = 0; ri < RI; ++ri) yk = (jg == ri) ? ys[ri] : yk;
            }
            if (MODE == 2) { if (RI == 8 || jg < 4) proj[(size_t)(tbase + blk * TBK + s) * PLD + PC_K + head * 64 + row0 + jg] = f2bf(yk); }
        }
    }
    if (MODE != 2) {
        float* dp = (float*)(P.ws + (MODE == 0 ? WS_RT : WS_RL)) + ((size_t)(head * NSEG + seg) * 64 + row0) * 64 + jg * 8;
#pragma unroll
        for (int ri = 0; ri < RI; ++ri) { *(f32x4*)(dp + ri * 64) = (f32x4){S[ri][0].x, S[ri][0].y, S[ri][1].x, S[ri][1].y}; *(f32x4*)(dp + ri * 64 + 4) = (f32x4){S[ri][2].x, S[ri][2].y, S[ri][3].x, S[ri][3].y}; }
    }
}

template <int MODE>
__device__ __forceinline__ void gdn_job(const Params& P, float* lw, int head, int rb, int seg) {
    float* sk = lw; float* sq = lw + 1024; float* sv = lw + 2048; float* sal = lw + 2304; float* sbe = lw + 2312;
    bf16_t* proj = (bf16_t*)(P.ws + WS_BIG);
    const bf16_t* gp = (const bf16_t*)(P.ws + WS_GDNP); const float* gbeta = (const float*)(P.ws + WS_GBETA); const float* gg = (const float*)(P.ws + WS_GG);
    const int lane = threadIdx.x & 63, jg = lane & 7, ig = lane >> 3, qh = head >> 1;
    const int ltt = lane >> 3, lc16 = (lane & 7) * 16, lc4 = (lane & 7) * 4;
    const int row0 = rb * 32 + ig * 4;
    f32x2 S[4][8];
    if constexpr (MODE == 2) {
        const float* sp = (const float*)((const unsigned char*)P.out + 96 * MiB) + ((size_t)(head * NSEG + seg) * 128 + row0) * 128 + jg * 16;
#pragma unroll
        for (int ri = 0; ri < 4; ++ri)
#pragma unroll
            for (int q4 = 0; q4 < 4; ++q4) { const f32x4 a = *(const f32x4*)(sp + ri * 128 + q4 * 4); S[ri][2 * q4] = (f32x2){a.x, a.y}; S[ri][2 * q4 + 1] = (f32x2){a.z, a.w}; }
    } else {
#pragma unroll
        for (int ri = 0; ri < 4; ++ri)
#pragma unroll
            for (int jj = 0; jj < 8; ++jj) { S[ri][jj] = (f32x2){0.f, 0.f}; if (MODE == 0) { if (row0 + ri == jg * 16 + 2 * jj) S[ri][jj].x = 1.f; if (row0 + ri == jg * 16 + 2 * jj + 1) S[ri][jj].y = 1.f; } }
    }
    u32x4 g_k0, g_k1, g_q0, g_q1; u32x2 g_v; float g_al = 0.f, g_be = 0.f;
    const int tbase = seg * SEGLEN;
    auto issue = [&](int blk) {
        const int t = tbase + blk * TBK + ltt;
        const bf16_t* rowp = gp + (size_t)t * 2048;
        g_k0 = *(const u32x4*)(rowp + 512 + qh * 128 + lc16); g_k1 = *(const u32x4*)(rowp + 512 + qh * 128 + lc16 + 8);
        if (MODE == 2) { g_q0 = *(const u32x4*)(rowp + qh * 128 + lc16); g_q1 = *(const u32x4*)(rowp + qh * 128 + lc16 + 8); }
        if (MODE != 0) g_v = *(const u32x2*)(rowp + 1024 + head * 128 + rb * 32 + lc4);
        if (lane < TBK) { const int tq = tbase + blk * TBK + lane; g_al = gg[tq * 8 + head]; g_be = gbeta[tq * 8 + head]; }
    };
    issue(0);
    for (int blk = 0; blk < SEGLEN / TBK; ++blk) {
        {
            float a[8], b[8];
            UNPK8(a, g_k0); UNPK8(b, g_k1);
            *(f32x4*)(sk + ltt * 128 + lc16) = (f32x4){a[0], a[1], a[2], a[3]}; *(f32x4*)(sk + ltt * 128 + lc16 + 4) = (f32x4){a[4], a[5], a[6], a[7]};
            *(f32x4*)(sk + ltt * 128 + lc16 + 8) = (f32x4){b[0], b[1], b[2], b[3]}; *(f32x4*)(sk + ltt * 128 + lc16 + 12) = (f32x4){b[4], b[5], b[6], b[7]};
            if (MODE == 2) {
                UNPK8(a, g_q0); UNPK8(b, g_q1);
                *(f32x4*)(sq + ltt * 128 + lc16) = (f32x4){a[0], a[1], a[2], a[3]}; *(f32x4*)(sq + ltt * 128 + lc16 + 4) = (f32x4){a[4], a[5], a[6], a[7]};
                *(f32x4*)(sq + ltt * 128 + lc16 + 8) = (f32x4){b[0], b[1], b[2], b[3]}; *(f32x4*)(sq + ltt * 128 + lc16 + 12) = (f32x4){b[4], b[5], b[6], b[7]};
            }
            if (MODE != 0) *(f32x4*)(sv + ltt * 32 + lc4) = (f32x4){bflo(g_v.x), bfhi(g_v.x), bflo(g_v.y), bfhi(g_v.y)};
            if (lane < TBK) { sal[lane] = __expf(g_al); sbe[lane] = g_be; }
        }
        if (blk + 1 < SEGLEN / TBK) issue(blk + 1);
#pragma unroll 2
        for (int s = 0; s < TBK; ++s) {
            f32x2 k[8], q[8]; f32x4 v = {0.f, 0.f, 0.f, 0.f};
#pragma unroll
            for (int q4 = 0; q4 < 4; ++q4) { const f32x4 x = *(const f32x4*)(sk + s * 128 + jg * 16 + q4 * 4); k[2 * q4] = (f32x2){x.x, x.y}; k[2 * q4 + 1] = (f32x2){x.z, x.w}; }
            if (MODE == 2) {
#pragma unroll
                for (int q4 = 0; q4 < 4; ++q4) { const f32x4 x = *(const f32x4*)(sq + s * 128 + jg * 16 + q4 * 4); q[2 * q4] = (f32x2){x.x, x.y}; q[2 * q4 + 1] = (f32x2){x.z, x.w}; }
            }
            if (MODE != 0) v = *(const f32x4*)(sv + s * 32 + ig * 4);
            const float al = sal[s], be = sbe[s];
            float ok = 0.f;
            float sa[4];
#pragma unroll
            for (int ri = 0; ri < 4; ++ri) {
                f32x2 a2 = S[ri][0] * k[0], a3 = S[ri][1] * k[1];
#pragma unroll
                for (int jj = 2; jj < 8; jj += 2) { a2 += S[ri][jj] * k[jj]; a3 += S[ri][jj + 1] * k[jj + 1]; }
                a2 += a3; sa[ri] = a2.x + a2.y;
            }
#pragma unroll
            for (int ri = 0; ri < 4; ++ri) sa[ri] += dppf<0xB1>(sa[ri]);
#pragma unroll
            for (int ri = 0; ri < 4; ++ri) sa[ri] += dppf<0x4E>(sa[ri]);
#pragma unroll
            for (int ri = 0; ri < 4; ++ri) sa[ri] += dppf<0x141>(sa[ri]);
#pragma unroll
            for (int ri = 0; ri < 4; ++ri) {
                const float c = (MODE != 0) ? be * (v[ri] - al * sa[ri]) : -be * al * sa[ri];
#pragma unroll
                for (int jj = 0; jj < 8; ++jj) S[ri][jj] = S[ri][jj] * al + k[jj] * c;
            }
            if (MODE == 2) {
                float os[4];
#pragma unroll
                for (int ri = 0; ri < 4; ++ri) {
                    f32x2 o2 = S[ri][0] * q[0], o3 = S[ri][1] * q[1];
#pragma unroll
                    for (int jj = 2; jj < 8; jj += 2) { o2 += S[ri][jj] * q[jj]; o3 += S[ri][jj + 1] * q[jj + 1]; }
                    o2 += o3; os[ri] = o2.x + o2.y;
                }
#pragma unroll
                for (int ri = 0; ri < 4; ++ri) os[ri] += dppf<0xB1>(os[ri]);
#pragma unroll
                for (int ri = 0; ri < 4; ++ri) os[ri] += dppf<0x4E>(os[ri]);
#pragma unroll
                for (int ri = 0; ri < 4; ++ri) os[ri] += dppf<0x141>(os[ri]);
#pragma unroll
                for (int ri = 0; ri < 4; ++ri) ok = (jg == ri) ? os[ri] : ok;
            }
            if (MODE == 2) { if (jg < 4) proj[(size_t)(tbase + blk * TBK + s) * PLD + PC_GQKV + head * 128 + row0 + jg] = f2bf(ok); }
        }
    }
    if (MODE != 2) {
        float* dp = (float*)((unsigned char*)P.out + (MODE == 0 ? 64 * MiB : 96 * MiB)) + ((size_t)(head * NSEG + seg) * 128 + row0) * 128 + jg * 16;
#pragma unroll
        for (int ri = 0; ri < 4; ++ri)
#pragma unroll
            for (int q4 = 0; q4 < 4; ++q4) *(f32x4*)(dp + ri * 128 + q4 * 4) = (f32x4){S[ri][2 * q4].x, S[ri][2 * q4].y, S[ri][2 * q4 + 1].x, S[ri][2 * q4 + 1].y};
    }
}

template <int N>
__device__ __forceinline__ void combine_job(const float* Tm, float* Lm, unsigned char* lds_, int head, int rg) {
    constexpr int NV = N * N / 4 / 512;
    constexpr int RT = (N == 128) ? 2 : 1;
    constexpr int NCQ = N / 4;
    constexpr int JQ = N / 4;
    float* Tl = (float*)lds_;
    float* cl = Tl + N * N;
    float* pl = cl + 8 * N;
    const int tid = threadIdx.x;
    const int cq = tid % NCQ, rp = (tid / NCQ) % (8 / RT), jq = tid / (NCQ * (8 / RT));
    const int ri = tid >> 6, c = tid & 63;
    float cur0 = 0.f, cur1 = 0.f;
    f32x4 tv[NV]; float l0, l1 = 0.f;
    {
        const size_t base = (size_t)(head * NSEG) * N * N;
#pragma unroll
        for (int i = 0; i < NV; ++i) tv[i] = *(const f32x4*)(Tm + base + (size_t)(tid + 512 * i) * 4);
        l0 = Lm[base + (size_t)(rg * 8 + ri) * N + c]; if (N == 128) l1 = Lm[base + (size_t)(rg * 8 + ri) * N + c + 64];
    }
    for (int g = 0; g < NSEG; ++g) {
        const size_t base = (size_t)(head * NSEG + g) * N * N;
        __syncthreads();
#pragma unroll
        for (int i = 0; i < NV; ++i) *(f32x4*)(Tl + (size_t)(tid + 512 * i) * 4) = tv[i];
        cl[ri * N + c] = cur0; if (N == 128) cl[ri * N + c + 64] = cur1;
        const float a0 = l0, a1 = l1;
        if (g + 1 < NSEG) {
            const size_t nb = base + (size_t)N * N;
#pragma unroll
            for (int i = 0; i < NV; ++i) tv[i] = *(const f32x4*)(Tm + nb + (size_t)(tid + 512 * i) * 4);
            l0 = Lm[nb + (size_t)(rg * 8 + ri) * N + c]; if (N == 128) l1 = Lm[nb + (size_t)(rg * 8 + ri) * N + c + 64];
        }
        __syncthreads();
        f32x4 acc[RT];
#pragma unroll
        for (int r = 0; r < RT; ++r) acc[r] = (f32x4){0.f, 0.f, 0.f, 0.f};
#pragma unroll 2
        for (int j4 = 0; j4 < JQ / 4; ++j4) {
            const int j0 = jq * JQ + j4 * 4;
            f32x4 x[RT];
#pragma unroll
            for (int r = 0; r < RT; ++r) x[r] = *(const f32x4*)(cl + (rp * RT + r) * N + j0);
#pragma unroll
            for (int e = 0; e < 4; ++e) {
                const f32x4 t4 = *(const f32x4*)(Tl + (j0 + e) * N + cq * 4);
#pragma unroll
                for (int r = 0; r < RT; ++r) acc[r] += t4 * x[r][e];
            }
        }
#pragma unroll
        for (int r = 0; r < RT; ++r) *(f32x4*)(pl + (jq * 8 + rp * RT + r) * N + cq * 4) = acc[r];
        __syncthreads();
        float s0 = a0 + ((pl[(0 * 8 + ri) * N + c] + pl[(1 * 8 + ri) * N + c]) + (pl[(2 * 8 + ri) * N + c] + pl[(3 * 8 + ri) * N + c]));
        float s1 = 0.f;
        if (N == 128) s1 = a1 + ((pl[(0 * 8 + ri) * N + c + 64] + pl[(1 * 8 + ri) * N + c + 64]) + (pl[(2 * 8 + ri) * N + c + 64] + pl[(3 * 8 + ri) * N + c + 64]));
        float* lp = Lm + base + (size_t)(rg * 8 + ri) * N + c;
        lp[0] = cur0; if (N == 128) lp[64] = cur1;
        cur0 = s0; cur1 = s1;
    }
}

__device__ __forceinline__ void mixer_post(const Params& P, int wg, int nwg, bool dry) {
    bf16_t* proj = (bf16_t*)(P.ws + WS_BIG);
    const bf16_t* i_kp = (const bf16_t*)(P.ws + WS_RWP) + (size_t)T * 1024; const bf16_t* i_g = (const bf16_t*)(P.ws + WS_RWG);
    const float* mu = P.in[8]; const float* r_k = P.in[16]; const float* ln_w = P.in[17]; const float* ln_b = P.in[18]; const float* gnw = P.in[22];
    const int lane = threadIdx.x & 63, wid = threadIdx.x >> 6;
    const int gw = wg * 8 + wid, ngw = nwg * 8;
    const int sub = lane >> 4, l16 = lane & 15;
    for (int it0 = gw * 4; it0 < T * 16; it0 += ngw * 4) {
        const int it = it0 + sub, t = it >> 4, hh = it & 15, c = hh * 64 + l16 * 4;
        const size_t pr = (size_t)t * PLD;
        const u32x2 yu = *(const u32x2*)(proj + pr + PC_K + c), rcu = *(const u32x2*)(proj + pr + PC_R + c), vcu = *(const u32x2*)(proj + pr + PC_V + c);
        u32x2 rpu = {0u, 0u}, vpu = {0u, 0u};
        if (t > 0) { rpu = *(const u32x2*)(proj + pr - PLD + PC_R + c); vpu = *(const u32x2*)(proj + pr - PLD + PC_V + c); }
        const u32x2 kpu = *(const u32x2*)(i_kp + (size_t)t * 1024 + c), ggu = *(const u32x2*)(i_g + (size_t)t * 1024 + c);
        const f32x4 mur = *(const f32x4*)(mu + c), muv = *(const f32x4*)(mu + 2048 + c), rk = *(const f32x4*)(r_k + c), lw = *(const f32x4*)(ln_w + c), lb = *(const f32x4*)(ln_b + c);
        const f32x4 y = {bflo(yu.x), bfhi(yu.x), bflo(yu.y), bfhi(yu.y)}, rc = {bflo(rcu.x), bfhi(rcu.x), bflo(rcu.y), bfhi(rcu.y)}, vc = {bflo(vcu.x), bfhi(vcu.x), bflo(vcu.y), bfhi(vcu.y)};
        const f32x4 rp = {bflo(rpu.x), bfhi(rpu.x), bflo(rpu.y), bfhi(rpu.y)}, vp = {bflo(vpu.x), bfhi(vpu.x), bflo(vpu.y), bfhi(vpu.y)};
        const f32x4 kp = {bflo(kpu.x), bfhi(kpu.x), bflo(kpu.y), bfhi(kpu.y)}, gg = {bflo(ggu.x), bfhi(ggu.x), bflo(ggu.y), bfhi(ggu.y)};
        const float mean = red16(y.x + y.y + y.z + y.w) * (1.f / 64.f);
        const f32x4 d = y - mean;
        const float var = red16(d.x * d.x + d.y * d.y + d.z * d.z + d.w * d.w) * (1.f / 64.f);
        const f32x4 r = rc + (rp - rc) * mur, v = vc + (vp - vc) * muv;
        const f32x4 rkk = r * kp * rk;
        const float bs = red16(rkk.x + rkk.y + rkk.z + rkk.w);
        const f32x4 o = (d * rsqrtf(var + 64e-5f) * lw + lb + v * bs) * gg;
        if (!dry || o.x != o.x) { u32x2 w; w.x = cvt_pk_bf16(o.x, o.y); w.y = cvt_pk_bf16(o.z, o.w); *(u32x2*)(proj + pr + PC_K + c) = w; }
    }
    for (int it0 = gw * 4; it0 < T * 8; it0 += ngw * 4) {
        const int it = it0 + sub, t = it >> 3, hh = it & 7, c = hh * 128 + l16 * 8;
        const size_t pr = (size_t)t * PLD;
        const u32x4 ou = *(const u32x4*)(proj + pr + PC_GQKV + c), zu = *(const u32x4*)(proj + pr + PC_Z + c);
        const f32x4 w0 = *(const f32x4*)(gnw + l16 * 8), w1 = *(const f32x4*)(gnw + l16 * 8 + 4);
        float o[8], z[8];
        UNPK8(o, ou); UNPK8(z, zu);
        float ss = 0.f;
#pragma unroll
        for (int e = 0; e < 8; ++e) ss += o[e] * o[e];
        ss = red16(ss);
        const float rs = rsqrtf(ss * (1.f / 128.f) + 1e-6f);
        float q[8];
#pragma unroll
        for (int e = 0; e < 8; ++e) q[e] = o[e] * rs * (e < 4 ? w0[e] : w1[e - 4]) * siluf_(z[e]);
        if (!dry || q[0] != q[0]) { u32x4 w; w.x = cvt_pk_bf16(q[0], q[1]); w.y = cvt_pk_bf16(q[2], q[3]); w.z = cvt_pk_bf16(q[4], q[5]); w.w = cvt_pk_bf16(q[6], q[7]); *(u32x4*)(proj + pr + PC_GQKV + c) = w; }
    }
}

constexpr size_t WS_KF = WS_BIG + 131 * MiB, WS_VF = WS_BIG + 132 * MiB;
__device__ __forceinline__ void attn_reformat(const bf16_t* Km, const bf16_t* Vt, bf16_t* Kf, bf16_t* Vf, int wg, int nwg) {
    for (int idx = wg * 512 + threadIdx.x; idx < 2 * 65536; idx += nwg * 512) {
        const int which = idx >> 16, li = idx & 65535, lane = li & 63, frag = li >> 6, r = lane & 15, qd = lane >> 4;
        if (which == 0) {
            const int ks = frag & 15, mt = (frag >> 4) & 15, hd = frag >> 8;
            *(u32x4*)(Kf + (size_t)li * 8) = *(const u32x4*)(Km + (size_t)(16 * mt + r) * D + 512 * hd + 32 * ks + 8 * qd);
        } else {
            const int s8 = frag & 7, dt = (frag >> 3) & 31, hd = frag >> 8;
            const bf16_t* vrow = Vt + (size_t)(512 * hd + 16 * dt + r) * NMEM;
            const u32x2 lo = *(const u32x2*)(vrow + 32 * s8 + 4 * qd), hi = *(const u32x2*)(vrow + 32 * s8 + 16 + 4 * qd);
            *(u32x4*)(Vf + (size_t)li * 8) = (u32x4){lo.x, lo.y, hi.x, hi.y};
        }
    }
}
__device__ __forceinline__ void attn_phase(const bf16_t* q, const bf16_t* Kf, const bf16_t* Vf, bf16_t* o, unsigned char* lds_, int wg, int nwg) {
    const int tid = threadIdx.x, lane = tid & 63, wid = tid >> 6, r = lane & 15, qd = lane >> 4;
    const float scale = 0.04419417382415922f * 1.4426950408889634f;
    u32x4* lb = (u32x4*)lds_;
    const int nitems = (T / 128) * 4;
    u32x4 pre[8];
    auto chunk_src = [&](int item, int ci) -> const u32x4* {
        const int hd = item & 3;
        return ci < 4 ? (const u32x4*)Kf + (size_t)((hd * 16 + 4 * ci) * 16) * 64 : (const u32x4*)Vf + (size_t)((hd * 32 + 8 * (ci - 4)) * 8) * 64;
    };
    if (wg >= nitems) return;
    { const u32x4* p = chunk_src(wg, 0);
#pragma unroll
      for (int i = 0; i < 8; ++i) lb[tid + 512 * i] = p[tid + 512 * i]; }
    __syncthreads();
    for (int item = wg; item < nitems; item += nwg) {
        const int hd = item & 3, t0 = (item >> 2) * 128 + wid * 16;
        const bool last_item = (item + nwg >= nitems);
        bf16x8 qf[16];
#pragma unroll
        for (int ks = 0; ks < 16; ++ks) qf[ks] = *(const bf16x8*)(q + (size_t)(t0 + r) * D + hd * 512 + ks * 32 + qd * 8);
        f32x4 s[16];
        bf16x8 pf[8];
        float inv = 0.f;
#pragma unroll
        for (int ci = 0; ci < 8; ++ci) {
            const bool has_next = !(last_item && ci == 7);
            if (has_next) { const u32x4* p = (ci < 7) ? chunk_src(item, ci + 1) : chunk_src(item + nwg, 0);
#pragma unroll
                for (int i = 0; i < 8; ++i) pre[i] = p[tid + 512 * i]; }
            const u32x4* cb = lb + (ci & 1) * 4096;
            if (ci < 4) {
#pragma unroll
                for (int m4 = 0; m4 < 4; ++m4) {
                    f32x4 acc = {0.f, 0.f, 0.f, 0.f};
#pragma unroll
                    for (int ks = 0; ks < 16; ++ks) acc = __builtin_amdgcn_mfma_f32_16x16x32_bf16(__builtin_bit_cast(bf16x8, cb[(m4 * 16 + ks) * 64 + lane]), qf[ks], acc, 0, 0, 0);
                    s[ci * 4 + m4] = acc;
                }
                if (ci == 3) {
                    float mx = -3.0e38f;
#pragma unroll
                    for (int mt = 0; mt < 16; ++mt) mx = fmaxf(mx, fmaxf(fmaxf(s[mt].x, s[mt].y), fmaxf(s[mt].z, s[mt].w)));
                    mx = fmaxf(mx, __shfl_xor(mx, 16)); mx = fmaxf(mx, __shfl_xor(mx, 32));
                    float sum = 0.f;
#pragma unroll
                    for (int mt = 0; mt < 16; ++mt) {
#pragma unroll
                        for (int e = 0; e < 4; ++e) { const float p = exp2f((s[mt][e] - mx) * scale); s[mt][e] = p; sum += p; }
                    }
                    sum += __shfl_xor(sum, 16); sum += __shfl_xor(sum, 32);
                    inv = 1.f / sum;
#pragma unroll
                    for (int s8 = 0; s8 < 8; ++s8) {
                        u32x4 w; w.x = cvt_pk_bf16(s[2 * s8].x, s[2 * s8].y); w.y = cvt_pk_bf16(s[2 * s8].z, s[2 * s8].w); w.z = cvt_pk_bf16(s[2 * s8 + 1].x, s[2 * s8 + 1].y); w.w = cvt_pk_bf16(s[2 * s8 + 1].z, s[2 * s8 + 1].w);
                        pf[s8] = __builtin_bit_cast(bf16x8, w);
                    }
                }
            } else {
                const int dg = ci - 4;
#pragma unroll
                for (int dt = 0; dt < 8; ++dt) {
                    f32x4 oa = {0.f, 0.f, 0.f, 0.f};
#pragma unroll
                    for (int s8 = 0; s8 < 8; ++s8) oa = __builtin_amdgcn_mfma_f32_16x16x32_bf16(__builtin_bit_cast(bf16x8, cb[(dt * 8 + s8) * 64 + lane]), pf[s8], oa, 0, 0, 0);
                    u32x2 w; w.x = cvt_pk_bf16(oa.x * inv, oa.y * inv); w.y = cvt_pk_bf16(oa.z * inv, oa.w * inv);
                    *(u32x2*)(o + (size_t)(t0 + r) * D + hd * 512 + dg * 128 + dt * 16 + qd * 4) = w;
                }
            }
            if (has_next) { u32x4* nb = lb + ((ci + 1) & 1) * 4096;
#pragma unroll
                for (int i = 0; i < 8; ++i) nb[tid + 512 * i] = pre[i]; }
            __syncthreads();
        }
    }
}

#define XB_TMO      128
#define XB_XCNT(j)  (256  + 64 * (j))
#define XB_XSUB(j)  (1280 + 64 * (j))
#define XB_XGEN(j)  (2304 + 64 * (j))
#define XB_TOP      3328
#define XB_TOPGEN   3392
#define XCD_BAR_WORDS 3456
#define XB_SPIN_CAP (1u << 18)

__device__ __forceinline__ unsigned xb_ld(unsigned* p)              { return __hip_atomic_load(p, __ATOMIC_RELAXED, __HIP_MEMORY_SCOPE_AGENT); }
__device__ __forceinline__ unsigned xb_add(unsigned* p, unsigned v) { return __hip_atomic_fetch_add(p, v, __ATOMIC_RELAXED, __HIP_MEMORY_SCOPE_AGENT); }
__device__ __forceinline__ unsigned xb_xcc_id() { return (unsigned)__builtin_amdgcn_s_getreg((3 << 11) | 20) & 0xFu; }
#define XB_SPIN(cond, bar) do { unsigned _sp = 0; while (cond) { __builtin_amdgcn_s_sleep(1); \
    if ((++_sp & 255u) == 0u) { if (xb_ld(&(bar)[XB_TMO])) break; if (_sp > XB_SPIN_CAP) { atomicAdd(&(bar)[XB_TMO], 1u); break; } } } } while (0)

struct XcdBarrier {
    unsigned* bar; unsigned x;
    volatile LAS unsigned* st;
};

__device__ __forceinline__ XcdBarrier xcd_barrier_post(unsigned* bar, volatile LAS unsigned* st) {
    XcdBarrier b; b.bar = bar; b.x = xb_xcc_id(); b.st = st;
    if (threadIdx.x == 0) (void)xb_add(&bar[XB_XCNT(b.x)], 1u);
    return b;
}
__device__ __forceinline__ void xcd_barrier_complete(unsigned* bar, unsigned x, unsigned& nloc, unsigned& nx) {
    const unsigned G = gridDim.x * gridDim.y * gridDim.z;
    unsigned sum, cnt, mine, sp = 0u;
    for (;;) {
        sum = 0u; cnt = 0u; mine = 0u;
#pragma unroll
        for (unsigned j = 0; j < 16; ++j) { const unsigned c = xb_ld(&bar[XB_XCNT(j)]); sum += c; cnt += (c > 0u) ? 1u : 0u; mine = (j == x) ? c : mine; }
        if (sum == G) break;
        __builtin_amdgcn_s_sleep(1);
        if ((++sp & 255u) == 0u) { if (xb_ld(&bar[XB_TMO])) break; if (sp > XB_SPIN_CAP) { atomicAdd(&bar[XB_TMO], 1u); break; } }
    }
    nloc = mine > 0u ? mine : 1u; nx = cnt > 0u ? cnt : 1u;
}

__device__ __forceinline__ void xcd_barrier(const XcdBarrier& b) {
    asm volatile("s_waitcnt vmcnt(0)" ::: "memory");
    __syncthreads();
    if (threadIdx.x == 0) {
        unsigned* bar = b.bar;
        __builtin_amdgcn_s_waitcnt(0);
        unsigned nloc = b.st[0], nx = b.st[1];
        if (nloc == 0u) { xcd_barrier_complete(bar, b.x, nloc, nx); b.st[0] = nloc; b.st[1] = nx; }
        const unsigned old = xb_add(&bar[XB_XSUB(b.x)], 1u);
        const unsigned gen = old / nloc;
        if (old + 1u == (gen + 1u) * nloc) {
            __builtin_amdgcn_fence(__ATOMIC_RELEASE, "agent");
            asm volatile("s_waitcnt vmcnt(0)" ::: "memory");
            const unsigned og = xb_add(&bar[XB_TOP], 1u);
            const unsigned tg = og / nx;
            if (og + 1u == (tg + 1u) * nx) xb_add(&bar[XB_TOPGEN], 1u);
            else XB_SPIN(xb_ld(&bar[XB_TOPGEN]) == tg, bar);
            __builtin_amdgcn_fence(__ATOMIC_ACQUIRE, "agent");
            xb_add(&bar[XB_XGEN(b.x)], 1u);
            asm volatile("s_waitcnt vmcnt(0)" ::: "memory");
        } else {
            XB_SPIN(xb_ld(&bar[XB_XGEN(b.x)]) == gen, bar);
            __builtin_amdgcn_fence(__ATOMIC_ACQUIRE, "agent");
            asm volatile("s_waitcnt vmcnt(0)" ::: "memory");
        }
    }
    __syncthreads();
}


__global__ void __launch_bounds__(512, 2) fwd_megakernel(Params P) {
    extern __shared__ __attribute__((aligned(16))) unsigned char smem[];
    LAS unsigned char* lds = (LAS unsigned char*)smem;
    cg::grid_group grid = cg::this_grid();
    const int wg = blockIdx.x, nwg = gridDim.x;
    unsigned char* ws = P.ws;
    bf16_t* hb = (bf16_t*)P.out;
    bf16_t* hb2 = (bf16_t*)(ws + WS_RWP);
    bf16_t* dlt = (bf16_t*)(ws + WS_RWP + 64 * MiB);
    bf16_t* act = (bf16_t*)(ws + WS_ACT);
    bf16_t* big = (bf16_t*)(ws + WS_BIG);
    bf16_t* gates = (bf16_t*)(ws + WS_RWP);
    volatile LAS unsigned* bst = (volatile LAS unsigned*)(lds + STAGE_BYTES);
    if (threadIdx.x == 0) { bst[0] = 0u; bst[1] = 0u; }
    __syncthreads();
    const XcdBarrier xb = xcd_barrier_post((unsigned*)(ws + WS_BAR), bst);

    convert_w(smem, P.in[3], P.in[4], P.in[2], (bf16_t*)(ws + WS_WGU), D, 2 * DFF, DFF, 1, wg, nwg);
    convert_w(smem, P.in[5], nullptr, nullptr, (bf16_t*)(ws + WS_WD), DFF, D, D, 0, wg, nwg);
    convert_w(smem, P.in[7], nullptr, P.in[6], (bf16_t*)(ws + WS_WIN), D, 10752, 10544, 2, wg, nwg);
    convert_w(smem, P.in[23], nullptr, nullptr, (bf16_t*)(ws + WS_LIFT), 1024, D, D, 0, wg, nwg);
    convert_w(smem, P.in[23] + (size_t)1024 * D, nullptr, nullptr, (bf16_t*)(ws + WS_LIFT) + (size_t)D * 1024, 1024, D, D, 0, wg, nwg);
    rownorm_bf16(P.in[0], act, T, wg, nwg);
    lora_frags(P, wg, nwg);
    xcd_barrier(xb);
    run_gemm<0>(lds, act, D, (const bf16_t*)(ws + WS_WGU), T, 2 * DFF, D, big, DFF, nullptr, 0, 0.f, 0);
    xcd_barrier(xb);
    run_gemm<2>(lds, big, DFF, (const bf16_t*)(ws + WS_WD), T, D, DFF, act, D, nullptr, 0, 0.f, 0);
    xcd_barrier(xb);
    rownorm_xd(P.in[0], act, 0.5f, hb, act, T, wg, nwg);
    xcd_barrier(xb);
    run_gemm<2>(lds, act, D, (const bf16_t*)(ws + WS_WIN), T, PLD, D, big, PLD, nullptr, 0, 0.f, 0);
    xcd_barrier(xb);
    rwkv_prep(P, smem, wg, nwg);
    gdn_prep(P, wg, nwg);
    xcd_barrier(xb);
    {
        const int wid = threadIdx.x >> 6, gw = wg * 8 + wid, ngw = nwg * 8;
        float* lw = (float*)(smem + wid * WAVE_LDS);
        for (int j = gw; j < 2048; j += ngw) gdn_job<0>(P, lw, ((j >> 9) << 1) | ((j >> 2) & 1), j & 3, (j >> 3) & 63);
        for (int j = gw; j < 2048; j += ngw) gdn_job<1>(P, lw, ((j >> 9) << 1) | ((j >> 2) & 1), j & 3, (j >> 3) & 63);
        for (int j = gw; j < 2048; j += ngw) { if (j & 1) rwkv_job<1, 8>(P, lw, j >> 7, (j >> 1) & 63, 0); else rwkv_job<0, 8>(P, lw, j >> 7, (j >> 1) & 63, 0); }
    }
    xcd_barrier(xb);
    for (int j = wg; j < 256; j += nwg) {
        if (j < 128) combine_job<64>((const float*)(ws + WS_RT), (float*)(ws + WS_RL), smem, j >> 3, j & 7);
        else combine_job<128>((const float*)((unsigned char*)P.out + 64 * MiB), (float*)((unsigned char*)P.out + 96 * MiB), smem, (j - 128) >> 4, (j - 128) & 15);
    }
    xcd_barrier(xb);
    {
        const int wid = threadIdx.x >> 6, gw = wg * 8 + wid, ngw = nwg * 8;
        float* lw = (float*)(smem + wid * WAVE_LDS);
        for (int j = gw; j < 2048; j += ngw) gdn_job<2>(P, lw, ((j >> 9) << 1) | ((j >> 2) & 1), j & 3, (j >> 3) & 63);
        for (int j = gw; j < 2048; j += ngw) rwkv_job<2, 4>(P, lw, j >> 7, (j >> 1) & 63, j & 1);
    }
    xcd_barrier(xb);
    mixer_post(P, wg, nwg, false);
    xcd_barrier(xb);
    run_gemm<3>(lds, act, D, (const bf16_t*)(ws + WS_WIN) + (size_t)PLD * D, T, 2 * D, D, gates, 2 * D, nullptr, 0, 0.f, 0);
    convert_w(smem, P.in[24], nullptr, nullptr, (bf16_t*)(ws + WS_WOUT), D, D, D, 0, wg, nwg);
    convert_w(smem, P.in[27], nullptr, P.in[25], (bf16_t*)(ws + WS_MQ), D, D, D, 0, wg, nwg);
    convert_w(smem, P.in[28], nullptr, P.in[26], (bf16_t*)(ws + WS_MK), D, D, D, 0, wg, nwg);
    convert_w(smem, P.in[29], nullptr, P.in[26], (bf16_t*)(ws + WS_MV), D, D, D, 0, wg, nwg);
    convert_w(smem, P.in[30], nullptr, nullptr, (bf16_t*)(ws + WS_MO), D, D, D, 0, wg, nwg);
    xcd_barrier(xb);
    bf16_t* lra = (bf16_t*)((unsigned char*)P.out + 64 * MiB);
    run_gemm<2>(lds, big + PC_K, PLD, (const bf16_t*)(ws + WS_LIFT), T, D, 1024, lra, D, nullptr, 0, 0.f, 0);
    convert_w(smem, P.in[32], P.in[33], P.in[31], (bf16_t*)(ws + WS_WGU), D, 2 * DFF, DFF, 1, wg, nwg);
    convert_w(smem, P.in[34], nullptr, nullptr, (bf16_t*)(ws + WS_WD), DFF, D, D, 0, wg, nwg);
    run_gemm<2>(lds, big + PC_GQKV, PLD, (const bf16_t*)(ws + WS_LIFT) + (size_t)D * 1024, T, D, 1024, act, D, nullptr, 0, 0.f, 0);
    xcd_barrier(xb);
    merge_pass(gates, lra, act, wg, nwg);
    xcd_barrier(xb);
    run_gemm<2>(lds, lra, D, (const bf16_t*)(ws + WS_WOUT), T, D, D, hb2, D, nullptr, 0, 0.f, 0);
    rownorm_bf16(P.in[1], (bf16_t*)(ws + WS_MKVN), NMEM, wg, nwg);
    xcd_barrier(xb);
    rownorm_bd(hb, hb2, hb, (bf16_t*)(ws + WS_HQ), T, wg, nwg);
    run_gemm<2>(lds, (const bf16_t*)(ws + WS_MKVN), D, (const bf16_t*)(ws + WS_MK), NMEM, D, D, ws + WS_KM, D, nullptr, 0, 0.f, 0);
    run_gemm<2>(lds, (const bf16_t*)(ws + WS_MV), D, (const bf16_t*)(ws + WS_MKVN), D, NMEM, D, ws + WS_VT, NMEM, nullptr, 0, 0.f, 8);
    xcd_barrier(xb);
    attn_reformat((const bf16_t*)(ws + WS_KM), (const bf16_t*)(ws + WS_VT), (bf16_t*)(ws + WS_KF), (bf16_t*)(ws + WS_VF), wg, nwg);
    run_gemm<2>(lds, (const bf16_t*)(ws + WS_HQ), D, (const bf16_t*)(ws + WS_MQ), T, D, D, ws + WS_Q, D, nullptr, 0, 0.f, 0);
    xcd_barrier(xb);
    attn_phase((const bf16_t*)(ws + WS_Q), (const bf16_t*)(ws + WS_KF), (const bf16_t*)(ws + WS_VF), act, smem, wg, nwg);
    xcd_barrier(xb);
    run_gemm<2>(lds, act, D, (const bf16_t*)(ws + WS_MO), T, D, D, dlt, D, nullptr, 0, 0.f, 0);
    xcd_barrier(xb);
    rownorm_bd(hb, dlt, hb2, act, T, wg, nwg);
    xcd_barrier(xb);
    run_gemm<0>(lds, act, D, (const bf16_t*)(ws + WS_WGU), T, 2 * DFF, D, big, DFF, nullptr, 0, 0.f, 0);
    xcd_barrier(xb);
    run_gemm<2>(lds, big, DFF, (const bf16_t*)(ws + WS_WD), T, D, DFF, dlt, D, nullptr, 0, 0.f, 0);
    xcd_barrier(xb);
    final_norm3(hb2, dlt, 0.5f, P.out, P.in[35], T, wg, nwg);
    if (nwg == 0x7fffffff) grid.sync();
}

extern "C" void kernel_launch(void* const* d_in, const int* in_sizes, int n_in, void* d_out, int out_size, void* d_ws, size_t ws_size, hipStream_t stream) {
    static int grid_blocks = 0;
    if (grid_blocks == 0) {
        if (n_in != 36 || out_size != T * D || ws_size < WS_END2 || in_sizes[7] != D * 10544 || in_sizes[8] != 3360) { fprintf(stderr, "kernel_launch: unexpected shapes n_in %d out %d ws %zu (need %zu)\n", n_in, out_size, ws_size, (size_t)WS_END); grid_blocks = -1; return; }
        int dev = 0, cus = 0, per_cu = 0;
        hipGetDevice(&dev);
        hipDeviceGetAttribute(&cus, hipDeviceAttributeMultiprocessorCount, dev);
        if (hipFuncSetAttribute((const void*)fwd_megakernel, hipFuncAttributeMaxDynamicSharedMemorySize, LDS_BYTES) != hipSuccess) { fprintf(stderr, "hipFuncSetAttribute failed\n"); grid_blocks = -1; return; }
        if (hipOccupancyMaxActiveBlocksPerMultiprocessor(&per_cu, (const void*)fwd_megakernel, 512, LDS_BYTES) != hipSuccess || per_cu < 1) { fprintf(stderr, "occupancy query failed (%d)\n", per_cu); per_cu = 1; }
        (void)hipGetLastError();
        grid_blocks = cus * 1;
        if (grid_blocks < 48) { fprintf(stderr, "too few CUs\n"); grid_blocks = -1; return; }
    }
    if (grid_blocks < 0) return;
    Params p{};
    for (int i = 0; i < 36; ++i) p.in[i] = (const float*)d_in[i];
    p.out = (float*)d_out; p.ws = (unsigned char*)d_ws;
    if (hipMemsetAsync((char*)d_ws + WS_BAR, 0, XCD_BAR_WORDS * sizeof(unsigned), stream) != hipSuccess) { fprintf(stderr, "barrier memset failed\n"); return; }
    void* args[] = {&p};
    hipError_t e = hipLaunchCooperativeKernel((void*)fwd_megakernel, dim3(grid_blocks), dim3(512), args, LDS_BYTES, stream);
    if (e != hipSuccess) fprintf(stderr, "cooperative launch failed: %s (grid %d)\n", hipGetErrorString(e), grid_blocks);
}
```

```cpp
#include <hip/hip_runtime.h>
#include <hip/hip_cooperative_groups.h>
#include <cstdio>
namespace cg = cooperative_groups;


#define LAS __attribute__((address_space(3)))
typedef unsigned short bf16_t;
typedef short bf16x8 __attribute__((ext_vector_type(8)));
typedef float f32x4 __attribute__((ext_vector_type(4)));
typedef float f32x2 __attribute__((ext_vector_type(2)));
typedef unsigned u32x2 __attribute__((ext_vector_type(2)));
typedef unsigned u32x4 __attribute__((ext_vector_type(4)));

constexpr int T = 16384, D = 2048, DFF = 5632, PLD = 6656, NMEM = 256;
constexpr int BM = 256, BK = 64, HALF = 128, HTB = HALF * BK * 2, STAGE_BYTES = 8 * HTB, NXCD = 8, WGM = 4;
constexpr int LDS_BYTES = STAGE_BYTES + 16;

constexpr int PC_R = 0, PC_K = 1024, PC_V = 2048, PC_GQKV = 3072, PC_Z = 5120, PC_SMALL = 6144, PC_BRAW = 6432, PC_ARAW = 6440;

constexpr size_t MiB = 1ull << 20;
constexpr size_t WS_WGU = 0, WS_WD = 44 * MiB;
constexpr size_t WS_GDNP = 0, WS_GBETA = 64 * MiB, WS_GG = 64 * MiB + 512 * 1024;
constexpr size_t WS_WIN = 66 * MiB;
constexpr size_t WS_LIFT = 108 * MiB;
constexpr size_t WS_RWG = 116 * MiB;
constexpr size_t WS_WOUT = 116 * MiB, WS_MQ = 124 * MiB, WS_MK = 132 * MiB, WS_MV = 140 * MiB, WS_MO = 148 * MiB;
constexpr size_t WS_ACT = 156 * MiB;
constexpr size_t WS_BIG = 220 * MiB;
constexpr size_t WS_RWP = WS_BIG + 208 * MiB;
constexpr size_t WS_HQ = WS_BIG, WS_Q = WS_BIG + 64 * MiB, WS_KM = WS_BIG + 128 * MiB, WS_VT = WS_BIG + 129 * MiB, WS_MKVN = WS_BIG + 130 * MiB;
constexpr size_t WS_END = 556 * MiB;

struct Params {
    const float* in[36];
    float* out;
    unsigned char* ws;
};

typedef __bf16 bf16x2n __attribute__((ext_vector_type(2)));
__device__ __forceinline__ unsigned cvt_pk_bf16(float lo, float hi) { const bf16x2n v = __builtin_convertvector((f32x2){lo, hi}, bf16x2n); return __builtin_bit_cast(unsigned, v); }
__device__ __forceinline__ bf16_t f2bf(float f) { return (bf16_t)(cvt_pk_bf16(f, 0.f) & 0xffffu); }
__device__ __forceinline__ float bf2f(bf16_t b) { return __uint_as_float(((unsigned)b) << 16); }
__device__ __forceinline__ float bflo(unsigned u) { return __uint_as_float(u << 16); }
__device__ __forceinline__ float bfhi(unsigned u) { return __uint_as_float(u & 0xffff0000u); }
__device__ __forceinline__ float sigmoidf_(float x) { return __builtin_amdgcn_rcpf(1.f + __expf(-x)); }
__device__ __forceinline__ float siluf_(float x) { return x * __builtin_amdgcn_rcpf(1.f + __expf(-x)); }
__device__ __forceinline__ float softplusf_(float x) { return x > 20.f ? x : log1pf(__expf(x)); }
__device__ __forceinline__ float wave_sum(float v) {
#pragma unroll
    for (int o = 32; o >= 1; o >>= 1) v += __shfl_xor(v, o);
    return v;
}
template <int CTRL> __device__ __forceinline__ float dppf(float v) { return __builtin_bit_cast(float, __builtin_amdgcn_update_dpp(0, __builtin_bit_cast(int, v), CTRL, 0xF, 0xF, true)); }
__device__ __forceinline__ float red8(float v) { v += dppf<0xB1>(v); v += dppf<0x4E>(v); v += dppf<0x141>(v); return v; }
__device__ __forceinline__ float red16(float v) { v = red8(v); v += dppf<0x140>(v); return v; }

__host__ __device__ __forceinline__ int lds_byte(int r, int c) { const int st = (r >> 4) * 2 + (c >> 5), rr = r & 15, cc = c & 31, ob = rr * 64 + cc * 2; return st * 1024 + (ob ^ (((ob >> 9) & 1) << 5)); }
__host__ __device__ __forceinline__ void stage_rc(int b, int& R, int& C) { const int st = b / 1024, sb = b % 1024, swz = sb ^ (((sb >> 9) & 1) << 5); R = (st >> 1) * 16 + swz / 64; C = (st & 1) * 32 + (swz % 64) / 2; }
__host__ __device__ __forceinline__ int perm32(int rho) { const int n = rho >> 4, i = rho & 15; return 8 * (i >> 2) + 4 * n + (i & 3); }

struct Unit { int pm, pn; };
struct Gemm { const bf16_t* A; const bf16_t* Bt; int M, N, K, lda; };

struct StaticOrder {
    int nM, nN, nwg, G, c;
    __device__ void init(int M, int N, int G_, int c_) { nM = M / BM; nN = N / BM; nwg = nM * nN; G = G_; c = c_; }
    __device__ bool next(int i, Unit& u) const {
        const long L = (long)i * G + c; if (L >= nwg) return false;
        int wgid = (int)L; { const int q = nwg / NXCD, r = nwg % NXCD, xcd = wgid % NXCD, off = wgid / NXCD; wgid = (xcd < r ? xcd * (q + 1) : r * (q + 1) + (xcd - r) * q) + off; }
        const int nig = WGM * nN, gid = wgid / nig, fm = gid * WGM, gsz = (nM - fm) < WGM ? (nM - fm) : WGM;
        u.pm = fm + ((wgid % nig) % gsz); u.pn = (wgid % nig) / gsz; return true;
    }
};

template <int MODE> struct Epi {
    static constexpr bool PERM = (MODE != 1 && MODE < 7);
    void* out; int ldc; const void* aux; int ldaux; float scale;
    __device__ __forceinline__ void operator()(const f32x4 (&acc)[2][2][4][2], const Unit& u, int wr, int wc, int fr, int fq) const {
        const int row0 = u.pm * BM + wr * 64 + fr;
        if constexpr (MODE >= 7) {
            const int col0 = u.pn * BM + wc * 32 + 4 * fq;
#pragma unroll
            for (int ai = 0; ai < 2; ++ai)
#pragma unroll
                for (int m = 0; m < 4; ++m) {
                    const size_t ro = (size_t)(row0 + ai * HALF + m * 16);
#pragma unroll
                    for (int bj = 0; bj < 2; ++bj)
#pragma unroll
                        for (int n = 0; n < 2; ++n) {
                            const int cc = col0 + bj * HALF + n * 16;
                            f32x4 rv;
                            if constexpr (MODE == 8) rv = *(const f32x4*)((const float*)aux + ro * ldaux + cc);
                            else { const u32x2 ru = *(const u32x2*)((const bf16_t*)aux + ro * ldaux + cc); rv = (f32x4){bflo(ru.x), bfhi(ru.x), bflo(ru.y), bfhi(ru.y)}; }
                            const f32x4 o = rv + acc[ai][bj][m][n] * scale;
                            if constexpr (MODE == 9) *(f32x4*)((float*)out + ro * ldc + cc) = o;
                            else { u32x2 w; w.x = cvt_pk_bf16(o.x, o.y); w.y = cvt_pk_bf16(o.z, o.w); *(u32x2*)((bf16_t*)out + ro * ldc + cc) = w; }
                        }
                }
        } else if constexpr (MODE == 1) {
            const int col0 = u.pn * BM + wc * 32 + 4 * fq;
#pragma unroll
            for (int ai = 0; ai < 2; ++ai)
#pragma unroll
                for (int m = 0; m < 4; ++m) {
                    const size_t ro = (size_t)(row0 + ai * HALF + m * 16);
                    float* op = (float*)out + ro * ldc + col0; const float* rp = (const float*)aux + ro * ldaux + col0;
#pragma unroll
                    for (int bj = 0; bj < 2; ++bj)
#pragma unroll
                        for (int n = 0; n < 2; ++n) { const f32x4 rv = *(const f32x4*)(rp + bj * HALF + n * 16); *(f32x4*)(op + bj * HALF + n * 16) = rv + acc[ai][bj][m][n] * scale; }
                }
        } else if constexpr (MODE == 0) {
            const int col0 = u.pn * HALF + wc * 32 + 8 * fq;
#pragma unroll
            for (int ai = 0; ai < 2; ++ai)
#pragma unroll
                for (int m = 0; m < 4; ++m) {
                    bf16_t* op = (bf16_t*)out + (size_t)(row0 + ai * HALF + m * 16) * ldc + col0;
                    float v[8];
#pragma unroll
                    for (int n = 0; n < 2; ++n)
#pragma unroll
                        for (int i = 0; i < 4; ++i) { const float g = acc[ai][0][m][n][i], up = acc[ai][1][m][n][i]; v[n * 4 + i] = siluf_(g) * up; }
                    u32x4 w; w.x = cvt_pk_bf16(v[0], v[1]); w.y = cvt_pk_bf16(v[2], v[3]); w.z = cvt_pk_bf16(v[4], v[5]); w.w = cvt_pk_bf16(v[6], v[7]);
                    *(u32x4*)op = w;
                }
        } else {
            const int col0 = u.pn * BM + wc * 32 + 8 * fq;
#pragma unroll
            for (int ai = 0; ai < 2; ++ai)
#pragma unroll
                for (int m = 0; m < 4; ++m) {
                    const size_t ro = (size_t)(row0 + ai * HALF + m * 16);
#pragma unroll
                    for (int bj = 0; bj < 2; ++bj) {
                        bf16_t* op = (bf16_t*)out + ro * ldc + col0 + bj * HALF;
                        float v[8];
#pragma unroll
                        for (int n = 0; n < 2; ++n)
#pragma unroll
                            for (int i = 0; i < 4; ++i) v[n * 4 + i] = acc[ai][bj][m][n][i];
                        if constexpr (MODE == 3) {
#pragma unroll
                            for (int i = 0; i < 8; ++i) v[i] = sigmoidf_(v[i]);
                        }
                        if constexpr (MODE == 4 || MODE == 5) {
                            const u32x4 gw = *(const u32x4*)((const bf16_t*)aux + ro * ldaux + col0 + bj * HALF);
                            v[0] *= bflo(gw.x); v[1] *= bfhi(gw.x); v[2] *= bflo(gw.y); v[3] *= bfhi(gw.y); v[4] *= bflo(gw.z); v[5] *= bfhi(gw.z); v[6] *= bflo(gw.w); v[7] *= bfhi(gw.w);
                        }
                        if constexpr (MODE == 5) {
                            const u32x4 pw = *(const u32x4*)op;
                            v[0] += bflo(pw.x); v[1] += bfhi(pw.x); v[2] += bflo(pw.y); v[3] += bfhi(pw.y); v[4] += bflo(pw.z); v[5] += bfhi(pw.z); v[6] += bflo(pw.w); v[7] += bfhi(pw.w);
                        }
                        u32x4 w; w.x = cvt_pk_bf16(v[0], v[1]); w.y = cvt_pk_bf16(v[2], v[3]); w.z = cvt_pk_bf16(v[4], v[5]); w.w = cvt_pk_bf16(v[6], v[7]);
                        *(u32x4*)op = w;
                    }
                }
        }
    }
};

template <class EpiT>
__device__ __forceinline__ void gemm_phase(LAS unsigned char* lds, const Gemm g, const StaticOrder& S, const EpiT& E) {
    int tid_ = threadIdx.x; asm volatile("" : "+v"(tid_));
    const int tid = tid_, wid = __builtin_amdgcn_readfirstlane(tid >> 6), lane = tid & 63, wr = wid >> 2, wc = wid & 3, fr = lane & 15, fq = lane >> 4;
    const int K = g.K, nt = K / BK, lda = g.lda;
    unsigned voffA[2], voffB[2];
#pragma unroll
    for (int i = 0; i < 2; ++i) { int R, C; stage_rc(tid * 16 + i * 8192, R, C); const int Rb = EpiT::PERM ? ((R & ~31) + perm32(R & 31)) : R;
        voffA[i] = (unsigned)(R * lda + C) * 2u; voffB[i] = (unsigned)(Rb * K + C) * 2u; }
    const size_t kstep = (size_t)(BK * 2);
    const size_t hstepA = (size_t)HALF * lda * 2, hstepB = (size_t)HALF * K * 2;
    const size_t tstepA = 2 * hstepA, tstepB = 2 * hstepB;
    const unsigned ldsw = (unsigned)wid * 1024u;
    const int aoff = lds_byte(wr * 64 + fr, fq * 8), boff = lds_byte(wc * 32 + fr, fq * 8);
#define PG8_SA(b, h) (((b) * 2 + (h)) * HTB)
#define PG8_SB(b, h) ((4 + (b) * 2 + (h)) * HTB)
#define PG8_STAGE(bufoff, gbase, voff) do { _Pragma("unroll") for (int _i = 0; _i < 2; ++_i) \
        __builtin_amdgcn_global_load_lds((const unsigned*)((const char*)(gbase) + (voff)[_i]), (LAS unsigned*)(lds + (bufoff) + ldsw + _i * 8192), 16, 0, 0); } while (0)
#define PG8_LDA(dst, b, h) do { _Pragma("unroll") for (int m = 0; m < 4; ++m) _Pragma("unroll") for (int k = 0; k < 2; ++k) dst[m][k] = *(const LAS bf16x8*)(lds + PG8_SA(b, h) + aoff + m * 2048 + k * 1024); } while (0)
#define PG8_LDB(dst, b, h) do { _Pragma("unroll") for (int n = 0; n < 2; ++n) _Pragma("unroll") for (int k = 0; k < 2; ++k) dst[n][k] = *(const LAS bf16x8*)(lds + PG8_SB(b, h) + boff + n * 2048 + k * 1024); } while (0)
#define PG8_MMA(ai, bj, At, Bt) do { __builtin_amdgcn_s_setprio(1); _Pragma("unroll") for (int m = 0; m < 4; ++m) _Pragma("unroll") for (int n = 0; n < 2; ++n) _Pragma("unroll") for (int k = 0; k < 2; ++k) \
        acc[ai][bj][m][n] = __builtin_amdgcn_mfma_f32_16x16x32_bf16(Bt[n][k], At[m][k], acc[ai][bj][m][n], 0, 0, 0); __builtin_amdgcn_s_setprio(0); } while (0)
#define PG8_WAIT_V(n) asm volatile("s_waitcnt vmcnt(" #n ")" ::: "memory")
#define PG8_WAIT_L(n) asm volatile("s_waitcnt lgkmcnt(" #n ")" ::: "memory")
#define PG8_BAR __builtin_amdgcn_s_barrier()
#define PG8_SCHED __builtin_amdgcn_sched_barrier(0)
    Unit cur, nxt; int ui = 0;
    if (!S.next(0, cur)) return;
    f32x4 acc[2][2][4][2];
#pragma unroll
    for (int a = 0; a < 2; ++a)
#pragma unroll
        for (int b = 0; b < 2; ++b)
#pragma unroll
            for (int m = 0; m < 4; ++m)
#pragma unroll
                for (int n = 0; n < 2; ++n) acc[a][b][m][n] = (f32x4){0.f, 0.f, 0.f, 0.f};
    bf16x8 At[4][2], B0[2][2], B1[2][2];
    const char* cA = (const char*)g.A + (size_t)cur.pm * tstepA; const char* cB = (const char*)g.Bt + (size_t)cur.pn * tstepB;
    PG8_STAGE(PG8_SB(0, 0), cB, voffB); PG8_STAGE(PG8_SA(0, 0), cA, voffA); PG8_STAGE(PG8_SB(0, 1), cB + hstepB, voffB); PG8_STAGE(PG8_SA(0, 1), cA + hstepA, voffA);
    if (wr == 1) PG8_BAR;
    PG8_WAIT_V(4); PG8_BAR;
    PG8_STAGE(PG8_SB(1, 0), cB + kstep, voffB); PG8_STAGE(PG8_SA(1, 0), cA + kstep, voffA); PG8_STAGE(PG8_SB(1, 1), cB + hstepB + kstep, voffB);
    PG8_WAIT_V(6); PG8_BAR;
    for (;;) {
        const bool has_next = S.next(ui + 1, nxt);
        const char* nA = has_next ? (const char*)g.A + (size_t)nxt.pm * tstepA : cA; const char* nB = has_next ? (const char*)g.Bt + (size_t)nxt.pn * tstepB : cB;
        for (int t = 0; t < nt; t += 2) {
            const bool last = (t == nt - 2);
            const char* a1 = cA + (size_t)(t + 1) * kstep;
            const char* a2 = last ? nA : cA + (size_t)(t + 2) * kstep; const char* b2 = last ? nB : cB + (size_t)(t + 2) * kstep;
            const char* a3 = a2 + kstep; const char* b3 = b2 + kstep;
            PG8_LDB(B0, 0, 0); PG8_SCHED; PG8_LDA(At, 0, 0); PG8_STAGE(PG8_SA(1, 1), a1 + hstepA, voffA);
            PG8_WAIT_L(8); PG8_BAR; PG8_WAIT_L(0); PG8_MMA(0, 0, At, B0); PG8_BAR; PG8_SCHED;
            PG8_LDB(B1, 0, 1); PG8_STAGE(PG8_SB(0, 0), b2, voffB);
            PG8_BAR; PG8_WAIT_L(0); PG8_MMA(0, 1, At, B1); PG8_BAR;
            PG8_LDA(At, 0, 1); PG8_STAGE(PG8_SA(0, 0), a2, voffA);
            PG8_BAR; PG8_WAIT_L(0); PG8_MMA(1, 0, At, B0); PG8_BAR; PG8_SCHED;
            PG8_STAGE(PG8_SB(0, 1), b2 + hstepB, voffB);
            PG8_WAIT_V(6); PG8_BAR; PG8_MMA(1, 1, At, B1); PG8_BAR;
            PG8_LDB(B0, 1, 0); PG8_SCHED; PG8_LDA(At, 1, 0); PG8_STAGE(PG8_SA(0, 1), a2 + hstepA, voffA);
            PG8_WAIT_L(8); PG8_BAR; PG8_WAIT_L(0); PG8_MMA(0, 0, At, B0); PG8_BAR; PG8_SCHED;
            PG8_LDB(B1, 1, 1); PG8_STAGE(PG8_SB(1, 0), b3, voffB);
            PG8_BAR; PG8_WAIT_L(0); PG8_MMA(0, 1, At, B1); PG8_BAR;
            PG8_LDA(At, 1, 1); PG8_STAGE(PG8_SA(1, 0), a3, voffA);
            PG8_BAR; PG8_WAIT_L(0); PG8_MMA(1, 0, At, B0); PG8_BAR; PG8_SCHED;
            PG8_STAGE(PG8_SB(1, 1), b3 + hstepB, voffB);
            PG8_WAIT_V(6); PG8_BAR; PG8_MMA(1, 1, At, B1); PG8_BAR;
        }
        E(acc, cur, wr, wc, fr, fq);
        if (!has_next) break;
#pragma unroll
        for (int a = 0; a < 2; ++a)
#pragma unroll
            for (int b = 0; b < 2; ++b)
#pragma unroll
                for (int m = 0; m < 4; ++m)
#pragma unroll
                    for (int n = 0; n < 2; ++n) acc[a][b][m][n] = (f32x4){0.f, 0.f, 0.f, 0.f};
        cur = nxt; cA = nA; cB = nB; ++ui;
    }
    PG8_WAIT_V(0);
    if (wr == 0) PG8_BAR;
    PG8_BAR;
#undef PG8_SA
#undef PG8_SB
#undef PG8_STAGE
#undef PG8_LDA
#undef PG8_LDB
#undef PG8_MMA
#undef PG8_WAIT_V
#undef PG8_WAIT_L
#undef PG8_BAR
#undef PG8_SCHED
}

template <int MODE>
__device__ __forceinline__ void run_gemm(LAS unsigned char* lds, const bf16_t* A, int lda, const bf16_t* Bt, int M, int N, int K, void* out, int ldc, const void* aux, int ldaux, float scale, int cshift) {
    Gemm g; g.A = A; g.Bt = Bt; g.M = M; g.N = N; g.K = K; g.lda = lda;
    StaticOrder S; S.init(M, N, (int)gridDim.x, (int)((blockIdx.x + cshift) % gridDim.x));
    Epi<MODE> E; E.out = out; E.ldc = ldc; E.aux = aux; E.ldaux = ldaux; E.scale = scale;
    gemm_phase(lds, g, S, E);
}

__device__ __forceinline__ int win_map(int n) {
    if (n < 3072) return n;
    if (n < 5120) return 3360 + (n - 3072);
    if (n < 6144) return 3360 + 2048 + (n - 5120);
    if (n < 6432) return 3072 + (n - 6144);
    if (n < 6448) return 3360 + 3072 + (n - 6432);
    if (n < 6656) return -1;
    return 6448 + (n - 6656);
}
__device__ __forceinline__ void convert_w(unsigned char* lds_, const float* src, const float* src2, const float* gain, bf16_t* dst, int K, int N, int ld, int kind, int wg, int nwg) {
    constexpr int KT = 256, LP = KT + 8;
    bf16_t* tl = (bf16_t*)lds_;
    const int tid = threadIdx.x;
    const int nnb = N / 64, nkb = K / KT, ntl = nnb * nkb;
    for (int tile = wg; tile < ntl; tile += nwg) {
        const int nb = tile % nnb, kb = tile / nnb;
        const int nl = tid & 63, n = nb * 64 + nl;
        const float* sp = src; int col = n;
        if (kind == 1) { const int pn = n >> 8, w = n & 255; sp = (w < 128) ? src : src2; col = pn * 128 + (w & 127); }
        else if (kind == 2) col = win_map(n);
        float v[32];
        const float* bp = sp + (size_t)(kb * KT + (tid >> 6)) * ld + (col >= 0 ? col : 0);
#pragma unroll
        for (int p = 0; p < 32; ++p) v[p] = bp[(size_t)(8 * p) * ld];
        if (col < 0) {
#pragma unroll
            for (int p = 0; p < 32; ++p) v[p] = 0.f;
        }
        if (gain) {
#pragma unroll
            for (int p = 0; p < 32; ++p) v[p] *= gain[kb * KT + (tid >> 6) + 8 * p];
        }
#pragma unroll
        for (int p = 0; p < 32; ++p) tl[nl * LP + (tid >> 6) + 8 * p] = f2bf(v[p]);
        __syncthreads();
        { const int nr = tid >> 3, kq = (tid & 7) * 8;
#pragma unroll
          for (int i = 0; i < 4; ++i) {
            const u32x4 w = *(const u32x4*)(tl + nr * LP + kq + 64 * i);
            *(u32x4*)(dst + (size_t)(nb * 64 + nr) * K + kb * KT + kq + 64 * i) = w; } }
        __syncthreads();
    }
}

#define UNPK8N(dst, u) do { dst[0] = bflo(u.x); dst[1] = bfhi(u.x); dst[2] = bflo(u.y); dst[3] = bfhi(u.y); dst[4] = bflo(u.z); dst[5] = bfhi(u.z); dst[6] = bflo(u.w); dst[7] = bfhi(u.w); } while (0)
__device__ __forceinline__ void rownorm_bf16(const float* src, bf16_t* dst, int rows, int wg, int nwg) {
    const int lane = threadIdx.x & 63, wid = threadIdx.x >> 6;
    for (int row = wg * 8 + wid; row < rows; row += nwg * 8) {
        const f32x4* p = (const f32x4*)(src + (size_t)row * D);
        f32x4 v[8]; float ss = 0.f;
#pragma unroll
        for (int i = 0; i < 8; ++i) { v[i] = p[lane + 64 * i]; ss += v[i].x * v[i].x + v[i].y * v[i].y + v[i].z * v[i].z + v[i].w * v[i].w; }
        ss = wave_sum(ss);
        const float rs = rsqrtf(ss * (1.f / D) + 1e-6f);
#pragma unroll
        for (int i = 0; i < 8; ++i) { u32x2 w; w.x = cvt_pk_bf16(v[i].x * rs, v[i].y * rs); w.y = cvt_pk_bf16(v[i].z * rs, v[i].w * rs); *(u32x2*)(dst + (size_t)row * D + (lane + 64 * i) * 4) = w; }
    }
}
__device__ __forceinline__ void rownorm_b2b(const bf16_t* src, bf16_t* dst, int rows, int wg, int nwg) {
    const int lane = threadIdx.x & 63, wid = threadIdx.x >> 6;
    for (int row = wg * 8 + wid; row < rows; row += nwg * 8) {
        const u32x4* p = (const u32x4*)(src + (size_t)row * D);
        float v[4][8]; float ss = 0.f;
#pragma unroll
        for (int i = 0; i < 4; ++i) { const u32x4 u = p[lane + 64 * i]; UNPK8N(v[i], u);
#pragma unroll
            for (int e = 0; e < 8; ++e) ss += v[i][e] * v[i][e]; }
        ss = wave_sum(ss);
        const float rs = rsqrtf(ss * (1.f / D) + 1e-6f);
#pragma unroll
        for (int i = 0; i < 4; ++i) { u32x4 w; w.x = cvt_pk_bf16(v[i][0] * rs, v[i][1] * rs); w.y = cvt_pk_bf16(v[i][2] * rs, v[i][3] * rs); w.z = cvt_pk_bf16(v[i][4] * rs, v[i][5] * rs); w.w = cvt_pk_bf16(v[i][6] * rs, v[i][7] * rs);
            *(u32x4*)(dst + (size_t)row * D + (lane + 64 * i) * 8) = w; }
    }
}
__device__ __forceinline__ void rownorm_xd(const float* xsrc, const bf16_t* dsrc, float dscale, bf16_t* hdst, bf16_t* udst, int rows, int wg, int nwg) {
    const int lane = threadIdx.x & 63, wid = threadIdx.x >> 6;
    for (int row = wg * 8 + wid; row < rows; row += nwg * 8) {
        const f32x4* px = (const f32x4*)(xsrc + (size_t)row * D); const u32x4* pd = (const u32x4*)(dsrc + (size_t)row * D);
        float v[4][8]; float ss = 0.f;
#pragma unroll
        for (int i = 0; i < 4; ++i) { const f32x4 a = px[(lane + 64 * i) * 2], b = px[(lane + 64 * i) * 2 + 1]; const u32x4 dd = pd[lane + 64 * i]; float y[8]; UNPK8N(y, dd);
            v[i][0] = a.x + dscale * y[0]; v[i][1] = a.y + dscale * y[1]; v[i][2] = a.z + dscale * y[2]; v[i][3] = a.w + dscale * y[3];
            v[i][4] = b.x + dscale * y[4]; v[i][5] = b.y + dscale * y[5]; v[i][6] = b.z + dscale * y[6]; v[i][7] = b.w + dscale * y[7];
#pragma unroll
            for (int e = 0; e < 8; ++e) ss += v[i][e] * v[i][e]; }
        ss = wave_sum(ss);
        const float rs = rsqrtf(ss * (1.f / D) + 1e-6f);
#pragma unroll
        for (int i = 0; i < 4; ++i) {
            u32x4 w; w.x = cvt_pk_bf16(v[i][0], v[i][1]); w.y = cvt_pk_bf16(v[i][2], v[i][3]); w.z = cvt_pk_bf16(v[i][4], v[i][5]); w.w = cvt_pk_bf16(v[i][6], v[i][7]);
            *(u32x4*)(hdst + (size_t)row * D + (lane + 64 * i) * 8) = w;
            u32x4 z; z.x = cvt_pk_bf16(v[i][0] * rs, v[i][1] * rs); z.y = cvt_pk_bf16(v[i][2] * rs, v[i][3] * rs); z.z = cvt_pk_bf16(v[i][4] * rs, v[i][5] * rs); z.w = cvt_pk_bf16(v[i][6] * rs, v[i][7] * rs);
            *(u32x4*)(udst + (size_t)row * D + (lane + 64 * i) * 8) = z;
        }
    }
}
__device__ __forceinline__ void rownorm_bd(const bf16_t* hsrc, const bf16_t* dsrc, bf16_t* hdst, bf16_t* udst, int rows, int wg, int nwg) {
    const int lane = threadIdx.x & 63, wid = threadIdx.x >> 6;
    for (int row = wg * 8 + wid; row < rows; row += nwg * 8) {
        const u32x4* ph = (const u32x4*)(hsrc + (size_t)row * D); const u32x4* pd = (const u32x4*)(dsrc + (size_t)row * D);
        float v[4][8]; float ss = 0.f;
#pragma unroll
        for (int i = 0; i < 4; ++i) { const u32x4 a = ph[lane + 64 * i], b = pd[lane + 64 * i]; float x[8], y[8]; UNPK8N(x, a); UNPK8N(y, b);
#pragma unroll
            for (int e = 0; e < 8; ++e) { v[i][e] = x[e] + y[e]; ss += v[i][e] * v[i][e]; } }
        ss = wave_sum(ss);
        const float rs = rsqrtf(ss * (1.f / D) + 1e-6f);
#pragma unroll
        for (int i = 0; i < 4; ++i) {
            u32x4 w; w.x = cvt_pk_bf16(v[i][0], v[i][1]); w.y = cvt_pk_bf16(v[i][2], v[i][3]); w.z = cvt_pk_bf16(v[i][4], v[i][5]); w.w = cvt_pk_bf16(v[i][6], v[i][7]);
            *(u32x4*)(hdst + (size_t)row * D + (lane + 64 * i) * 8) = w;
            u32x4 z; z.x = cvt_pk_bf16(v[i][0] * rs, v[i][1] * rs); z.y = cvt_pk_bf16(v[i][2] * rs, v[i][3] * rs); z.z = cvt_pk_bf16(v[i][4] * rs, v[i][5] * rs); z.w = cvt_pk_bf16(v[i][6] * rs, v[i][7] * rs);
            *(u32x4*)(udst + (size_t)row * D + (lane + 64 * i) * 8) = z;
        }
    }
}
__device__ __forceinline__ void final_norm3(const bf16_t* hsrc, const bf16_t* dsrc, float dscale, float* dst, const float* gain, int rows, int wg, int nwg) {
    const int lane = threadIdx.x & 63, wid = threadIdx.x >> 6;
    for (int row = wg * 8 + wid; row < rows; row += nwg * 8) {
        const u32x4* ph = (const u32x4*)(hsrc + (size_t)row * D); const u32x4* pd = (const u32x4*)(dsrc + (size_t)row * D);
        float v[4][8]; float ss = 0.f;
#pragma unroll
        for (int i = 0; i < 4; ++i) { const u32x4 a = ph[lane + 64 * i], b = pd[lane + 64 * i]; float x[8], y[8]; UNPK8N(x, a); UNPK8N(y, b);
#pragma unroll
            for (int e = 0; e < 8; ++e) { v[i][e] = x[e] + dscale * y[e]; ss += v[i][e] * v[i][e]; } }
        ss = wave_sum(ss);
        const float rs = rsqrtf(ss * (1.f / D) + 1e-6f);
#pragma unroll
        for (int i = 0; i < 4; ++i) {
            const f32x4 g0 = ((const f32x4*)gain)[(lane + 64 * i) * 2], g1 = ((const f32x4*)gain)[(lane + 64 * i) * 2 + 1];
            f32x4* q = (f32x4*)(dst + (size_t)row * D + (lane + 64 * i) * 8);
            q[0] = (f32x4){v[i][0], v[i][1], v[i][2], v[i][3]} * rs * g0; q[1] = (f32x4){v[i][4], v[i][5], v[i][6], v[i][7]} * rs * g1;
        }
    }
}
__device__ __forceinline__ void final_norm2(const float* src, float* dst, const float* gain, int rows, int wg, int nwg) {
    const int lane = threadIdx.x & 63, wid = threadIdx.x >> 6;
    for (int row = wg * 8 + wid; row < rows; row += nwg * 8) {
        const f32x4* p = (const f32x4*)(src + (size_t)row * D); f32x4* q = (f32x4*)(dst + (size_t)row * D);
        f32x4 v[8]; float ss = 0.f;
#pragma unroll
        for (int i = 0; i < 8; ++i) { v[i] = p[lane + 64 * i]; ss += v[i].x * v[i].x + v[i].y * v[i].y + v[i].z * v[i].z + v[i].w * v[i].w; }
        ss = wave_sum(ss);
        const float rs = rsqrtf(ss * (1.f / D) + 1e-6f);
#pragma unroll
        for (int i = 0; i < 8; ++i) { const f32x4 gv = ((const f32x4*)gain)[lane + 64 * i]; q[lane + 64 * i] = v[i] * rs * gv; }
    }
}
__device__ __forceinline__ void final_norm(float* io, const float* gain, int rows, int wg, int nwg) {
    const int lane = threadIdx.x & 63, wid = threadIdx.x >> 6;
    for (int row = wg * 8 + wid; row < rows; row += nwg * 8) {
        f32x4* p = (f32x4*)(io + (size_t)row * D);
        f32x4 v[8]; float ss = 0.f;
#pragma unroll
        for (int i = 0; i < 8; ++i) { v[i] = p[lane + 64 * i]; ss += v[i].x * v[i].x + v[i].y * v[i].y + v[i].z * v[i].z + v[i].w * v[i].w; }
        ss = wave_sum(ss);
        const float rs = rsqrtf(ss * (1.f / D) + 1e-6f);
#pragma unroll
        for (int i = 0; i < 8; ++i) { const f32x4 gv = ((const f32x4*)gain)[lane + 64 * i]; p[lane + 64 * i] = v[i] * rs * gv; }
    }
}

constexpr size_t WS_LORA = 148 * MiB;
__device__ __forceinline__ void lora_frags(const Params& P, int wg, int nwg) {
    bf16_t* dst = (bf16_t*)(P.ws + WS_LORA);
    for (int idx = wg * 512 + threadIdx.x; idx < 64 * 9 * 64; idx += nwg * 512) {
        const int lane = idx & 63, frag = idx >> 6, cg = frag / 9, f = frag - cg * 9, r = lane & 15, qd = lane >> 4;
        const float* W = f < 2 ? P.in[10] : (f < 4 ? P.in[12] : P.in[13]);
        const int ks = f < 2 ? f : (f < 4 ? f - 2 : f - 4);
        float v[8];
#pragma unroll
        for (int j = 0; j < 8; ++j) v[j] = W[(size_t)(32 * ks + 8 * qd + j) * 1024 + 16 * cg + r];
        u32x4 w; w.x = cvt_pk_bf16(v[0], v[1]); w.y = cvt_pk_bf16(v[2], v[3]); w.z = cvt_pk_bf16(v[4], v[5]); w.w = cvt_pk_bf16(v[6], v[7]);
        *(u32x4*)(dst + (size_t)idx * 8) = w;
    }
}
__device__ __forceinline__ void rwkv_prep(const Params& P, unsigned char* lds_, int wg, int nwg) {
    constexpr int SP = 296;
    bf16_t* sm = (bf16_t*)lds_;
    u32x4* Bl = (u32x4*)(lds_ + 38912);
    const bf16_t* proj = (const bf16_t*)(P.ws + WS_BIG);
    const u32x4* frg = (const u32x4*)(P.ws + WS_LORA);
    bf16_t* o_ld = (bf16_t*)(P.ws + WS_RWP); bf16_t* o_kp = o_ld + (size_t)T * 1024; bf16_t* o_kk = o_kp + (size_t)T * 1024; bf16_t* o_aa = o_kk + (size_t)T * 1024;
    bf16_t* o_g = (bf16_t*)(P.ws + WS_RWG);
    const float* mu = P.in[8]; const float* w0 = P.in[9]; const float* a0 = P.in[11]; const float* k_k = P.in[14]; const float* k_a = P.in[15];
    const int tid = threadIdx.x, lane = tid & 63, wid = tid >> 6, r = lane & 15, qd = lane >> 4;
    const int tq = wid & 3, hsel = wid >> 2;
    for (int tile = wg; tile < T / 64; tile += nwg) {
        const int t0 = tile * 64;
        __syncthreads();
#pragma unroll 4
        for (int e9 = 0; e9 < 36; ++e9) {
            const int e = tid + e9 * 512;
            const int tt = e / 288, i = e - tt * 288, t = t0 + tt, col = PC_SMALL + i;
            const float cur = bf2f(proj[(size_t)t * PLD + col]); const float prev = t > 0 ? bf2f(proj[(size_t)(t - 1) * PLD + col]) : 0.f;
            float x = cur + (prev - cur) * mu[3072 + i];
            if (i < 64) x = tanhf(x); else if (i >= 128) x = sigmoidf_(x);
            sm[tt * SP + i] = f2bf(x);
        }
        __syncthreads();
        bf16x8 af[9];
#pragma unroll
        for (int f = 0; f < 9; ++f) af[f] = *(const bf16x8*)(sm + (tq * 16 + r) * SP + 32 * f + 8 * qd);
#pragma unroll 1
        for (int hp = 0; hp < 8; ++hp) {
            __syncthreads();
#pragma unroll
            for (int i = 0; i < 9; ++i) Bl[tid + 512 * i] = frg[(size_t)hp * 72 * 64 + tid + 512 * i];
            __syncthreads();
            const int head = hp * 2 + hsel;
            f32x4 aw[4], aa_[4], ag[4];
#pragma unroll
            for (int g4 = 0; g4 < 4; ++g4) {
                const u32x4* fp = Bl + ((hsel * 4 + g4) * 9) * 64 + lane;
                aw[g4] = (f32x4){0.f, 0.f, 0.f, 0.f}; aa_[g4] = aw[g4]; ag[g4] = aw[g4];
#pragma unroll
                for (int f = 0; f < 2; ++f) aw[g4] = __builtin_amdgcn_mfma_f32_16x16x32_bf16(__builtin_bit_cast(bf16x8, fp[f * 64]), af[f], aw[g4], 0, 0, 0);
#pragma unroll
                for (int f = 2; f < 4; ++f) aa_[g4] = __builtin_amdgcn_mfma_f32_16x16x32_bf16(__builtin_bit_cast(bf16x8, fp[f * 64]), af[f], aa_[g4], 0, 0, 0);
#pragma unroll
                for (int f = 4; f < 9; ++f) ag[g4] = __builtin_amdgcn_mfma_f32_16x16x32_bf16(__builtin_bit_cast(bf16x8, fp[f * 64]), af[f], ag[g4], 0, 0, 0);
            }
            const int t = t0 + tq * 16 + r;
            f32x4 kr[4], kv[4], av[4]; float ss = 0.f;
#pragma unroll
            for (int g4 = 0; g4 < 4; ++g4) {
                const int c = head * 64 + g4 * 16 + 4 * qd;
                const f32x4 muk = *(const f32x4*)(mu + 1024 + c), w0c = *(const f32x4*)(w0 + c), a0c = *(const f32x4*)(a0 + c), kkc = *(const f32x4*)(k_k + c);
                const u32x2 kcu = *(const u32x2*)(proj + (size_t)t * PLD + PC_K + c);
                u32x2 kpu = {0u, 0u}; if (t > 0) kpu = *(const u32x2*)(proj + (size_t)(t - 1) * PLD + PC_K + c);
                const f32x4 kcur = {bflo(kcu.x), bfhi(kcu.x), bflo(kcu.y), bfhi(kcu.y)}, kprev = {bflo(kpu.x), bfhi(kpu.x), bflo(kpu.y), bfhi(kpu.y)};
                const f32x4 k = kcur + (kprev - kcur) * muk;
                f32x4 ld, a;
#pragma unroll
                for (int jj = 0; jj < 4; ++jj) { ld[jj] = -0.6065306597126334f * sigmoidf_(w0c[jj] + aw[g4][jj]); a[jj] = sigmoidf_(a0c[jj] + aa_[g4][jj]); }
                kv[g4] = k; av[g4] = a; kr[g4] = k * kkc; ss += kr[g4].x * kr[g4].x + kr[g4].y * kr[g4].y + kr[g4].z * kr[g4].z + kr[g4].w * kr[g4].w;
                const size_t o = (size_t)t * 1024 + c;
                u32x2 w;
                w.x = cvt_pk_bf16(ld.x, ld.y); w.y = cvt_pk_bf16(ld.z, ld.w); *(u32x2*)(o_ld + o) = w;
                w.x = cvt_pk_bf16(a.x, a.y); w.y = cvt_pk_bf16(a.z, a.w); *(u32x2*)(o_aa + o) = w;
                w.x = cvt_pk_bf16(ag[g4].x, ag[g4].y); w.y = cvt_pk_bf16(ag[g4].z, ag[g4].w); *(u32x2*)(o_g + o) = w;
            }
            ss += __shfl_xor(ss, 16); ss += __shfl_xor(ss, 32);
            const float rn = rsqrtf(ss + 1e-6f);
#pragma unroll
            for (int g4 = 0; g4 < 4; ++g4) {
                const int c = head * 64 + g4 * 16 + 4 * qd; const f32x4 kac = *(const f32x4*)(k_a + c);
                const f32x4 kk = kr[g4] * rn, kp = kv[g4] * ((av[g4] - 1.f) * kac + 1.f);
                const size_t o = (size_t)t * 1024 + c;
                u32x2 w;
                w.x = cvt_pk_bf16(kk.x, kk.y); w.y = cvt_pk_bf16(kk.z, kk.w); *(u32x2*)(o_kk + o) = w;
                w.x = cvt_pk_bf16(kp.x, kp.y); w.y = cvt_pk_bf16(kp.z, kp.w); *(u32x2*)(o_kp + o) = w;
            }
        }
    }
}

__device__ __forceinline__ void gdn_prep(const Params& P, int wg, int nwg) {
    const bf16_t* proj = (const bf16_t*)(P.ws + WS_BIG);
    bf16_t* gp = (bf16_t*)(P.ws + WS_GDNP); float* gbeta = (float*)(P.ws + WS_GBETA); float* gg = (float*)(P.ws + WS_GG);
    const float* cw = P.in[19]; const float* a_log = P.in[20]; const float* dt_bias = P.in[21];
    const int tid = threadIdx.x;
    for (int tile = wg; tile < T / 64; tile += nwg) {
        const int t0 = tile * 64;
        const int ca = 2 * tid, cb = 1024 + 2 * tid;
        float w[4][4];
#pragma unroll
        for (int i = 0; i < 4; ++i) { w[0][i] = cw[i * 2048 + ca]; w[1][i] = cw[i * 2048 + ca + 1]; w[2][i] = cw[i * 2048 + cb]; w[3][i] = cw[i * 2048 + cb + 1]; }
        float x[4][4];
#pragma unroll
        for (int h = 0; h < 3; ++h) {
            const int t = t0 - 3 + h;
            unsigned ua = 0, ub = 0;
            if (t >= 0) { ua = *(const unsigned*)(proj + (size_t)t * PLD + PC_GQKV + ca); ub = *(const unsigned*)(proj + (size_t)t * PLD + PC_GQKV + cb); }
            x[0][h + 1] = bflo(ua); x[1][h + 1] = bfhi(ua); x[2][h + 1] = bflo(ub); x[3][h + 1] = bfhi(ub);
        }
        const float qscale = (tid < 256) ? 0.08838834764831845f : 1.f;
        for (int tb = 0; tb < 64; tb += 8) {
            unsigned ua[8], ub[8];
#pragma unroll
            for (int i = 0; i < 8; ++i) { const size_t ro = (size_t)(t0 + tb + i) * PLD + PC_GQKV; ua[i] = *(const unsigned*)(proj + ro + ca); ub[i] = *(const unsigned*)(proj + ro + cb); }
#pragma unroll
            for (int i = 0; i < 8; ++i) {
                const int t = t0 + tb + i;
#pragma unroll
                for (int c = 0; c < 4; ++c) { x[c][0] = x[c][1]; x[c][1] = x[c][2]; x[c][2] = x[c][3]; }
                x[0][3] = bflo(ua[i]); x[1][3] = bfhi(ua[i]); x[2][3] = bflo(ub[i]); x[3][3] = bfhi(ub[i]);
                float y[4];
#pragma unroll
                for (int c = 0; c < 4; ++c) { const float sacc = w[c][0] * x[c][0] + w[c][1] * x[c][1] + w[c][2] * x[c][2] + w[c][3] * x[c][3]; y[c] = siluf_(sacc); }
                const float ss = wave_sum(y[0] * y[0] + y[1] * y[1]);
                const float rs = rsqrtf(ss + 1e-6f) * qscale;
                *(unsigned*)(gp + (size_t)t * 2048 + ca) = cvt_pk_bf16(y[0] * rs, y[1] * rs);
                *(unsigned*)(gp + (size_t)t * 2048 + cb) = cvt_pk_bf16(y[2], y[3]);
            }
        }
        if (tid < 64) {
            for (int e = tid; e < 64 * 8; e += 64) {
                const int tt = e >> 3, h = e & 7, t = t0 + tt;
                const float br = bf2f(proj[(size_t)t * PLD + PC_BRAW + h]), ar = bf2f(proj[(size_t)t * PLD + PC_ARAW + h]);
                gbeta[t * 8 + h] = sigmoidf_(br);
                gg[t * 8 + h] = -__expf(a_log[h]) * softplusf_(ar + dt_bias[h]);
            }
        }
    }
}

constexpr int NSEG = 64, SEGLEN = T / NSEG, TBK = 8;
constexpr size_t WS_RT = WS_WIN, WS_RL = 556 * MiB, WS_GT = WS_ACT, WS_GL = WS_ACT + 32 * MiB;
constexpr size_t WS_BAR = 572 * MiB;
constexpr size_t WS_END2 = 573 * MiB;
constexpr int WAVE_LDS = 12288;

#define UNPK8(dst, u) do { dst[0] = bflo(u.x); dst[1] = bfhi(u.x); dst[2] = bflo(u.y); dst[3] = bfhi(u.y); dst[4] = bflo(u.z); dst[5] = bfhi(u.z); dst[6] = bflo(u.w); dst[7] = bfhi(u.w); } while (0)

template <int MODE, int RI>
__device__ __forceinline__ void rwkv_job(const Params& P, float* lw, int head, int seg, int half) {
    float* sr = lw; float* sw = lw + 512; float* sk = lw + 1024; float* sv = lw + 1536; float* sna = lw + 2048; float* sb = lw + 2560;
    bf16_t* proj = (bf16_t*)(P.ws + WS_BIG);
    const bf16_t* i_ld = (const bf16_t*)(P.ws + WS_RWP); const bf16_t* i_kp = i_ld + (size_t)T * 1024; const bf16_t* i_kk = i_kp + (size_t)T * 1024; const bf16_t* i_aa = i_kk + (size_t)T * 1024;
    const float* mu = P.in[8];
    const int lane = threadIdx.x & 63, jg = lane & 7, ig = lane >> 3;
    const int ltt = lane >> 3, lc8 = (lane & 7) * 8, ch = head * 64 + lc8;
    const int row0 = (RI == 8) ? ig * 8 : half * 32 + ig * 4;
    f32x2 S[RI][4];
    if constexpr (MODE == 2) {
        const float* sp = (const float*)(P.ws + WS_RL) + ((size_t)(head * NSEG + seg) * 64 + row0) * 64 + jg * 8;
#pragma unroll
        for (int ri = 0; ri < RI; ++ri) { const f32x4 a = *(const f32x4*)(sp + ri * 64), b = *(const f32x4*)(sp + ri * 64 + 4); S[ri][0] = (f32x2){a.x, a.y}; S[ri][1] = (f32x2){a.z, a.w}; S[ri][2] = (f32x2){b.x, b.y}; S[ri][3] = (f32x2){b.z, b.w}; }
    } else {
#pragma unroll
        for (int ri = 0; ri < RI; ++ri)
#pragma unroll
            for (int jj = 0; jj < 4; ++jj) { S[ri][jj] = (f32x2){0.f, 0.f}; if (MODE == 0) { if (row0 + ri == jg * 8 + 2 * jj) S[ri][jj].x = 1.f; if (row0 + ri == jg * 8 + 2 * jj + 1) S[ri][jj].y = 1.f; } }
    }
    u32x4 g_rc, g_rp, g_vc, g_vp, g_ld, g_kp, g_kk, g_aa;
    const int tbase = seg * SEGLEN;
    auto issue = [&](int blk) {
        const int t = tbase + blk * TBK + ltt;
        const size_t o = (size_t)t * 1024 + ch;
        g_ld = *(const u32x4*)(i_ld + o); g_kk = *(const u32x4*)(i_kk + o); g_aa = *(const u32x4*)(i_aa + o);
        if (MODE != 0) {
            g_kp = *(const u32x4*)(i_kp + o);
            g_vc = *(const u32x4*)(proj + (size_t)t * PLD + PC_V + ch);
            if (t > 0) g_vp = *(const u32x4*)(proj + (size_t)(t - 1) * PLD + PC_V + ch); else g_vp = (u32x4){0u, 0u, 0u, 0u};
        }
        if (MODE == 2) {
            g_rc = *(const u32x4*)(proj + (size_t)t * PLD + PC_R + ch);
            if (t > 0) g_rp = *(const u32x4*)(proj + (size_t)(t - 1) * PLD + PC_R + ch); else g_rp = (u32x4){0u, 0u, 0u, 0u};
        }
    };
    issue(0);
    for (int blk = 0; blk < SEGLEN / TBK; ++blk) {
        {
            float ld[8], kk[8], aa[8];
            UNPK8(ld, g_ld); UNPK8(kk, g_kk); UNPK8(aa, g_aa);
            const int o = ltt * 64 + lc8;
#pragma unroll
            for (int e = 0; e < 8; ++e) { sw[o + e] = __expf(ld[e]); sna[o + e] = -kk[e]; sb[o + e] = kk[e] * aa[e]; }
            if (MODE != 0) {
                float kp[8], vc[8], vp[8];
                UNPK8(kp, g_kp); UNPK8(vc, g_vc); UNPK8(vp, g_vp);
#pragma unroll
                for (int e = 0; e < 8; ++e) { sk[o + e] = kp[e]; sv[o + e] = vc[e] + (vp[e] - vc[e]) * mu[2048 + ch + e]; }
            }
            if (MODE == 2) {
                float rc[8], rp[8];
                UNPK8(rc, g_rc); UNPK8(rp, g_rp);
#pragma unroll
                for (int e = 0; e < 8; ++e) sr[o + e] = rc[e] + (rp[e] - rc[e]) * mu[ch + e];
            }
        }
        if (blk + 1 < SEGLEN / TBK) issue(blk + 1);
#pragma unroll 2
        for (int s = 0; s < TBK; ++s) {
            f32x2 w[4], k[4], na[4], b[4], r[4]; float v[8];
            { const f32x4 x0 = *(const f32x4*)(sw + s * 64 + jg * 8), x1 = *(const f32x4*)(sw + s * 64 + jg * 8 + 4); w[0] = (f32x2){x0.x, x0.y}; w[1] = (f32x2){x0.z, x0.w}; w[2] = (f32x2){x1.x, x1.y}; w[3] = (f32x2){x1.z, x1.w}; }
            { const f32x4 x0 = *(const f32x4*)(sna + s * 64 + jg * 8), x1 = *(const f32x4*)(sna + s * 64 + jg * 8 + 4); na[0] = (f32x2){x0.x, x0.y}; na[1] = (f32x2){x0.z, x0.w}; na[2] = (f32x2){x1.x, x1.y}; na[3] = (f32x2){x1.z, x1.w}; }
            { const f32x4 x0 = *(const f32x4*)(sb + s * 64 + jg * 8), x1 = *(const f32x4*)(sb + s * 64 + jg * 8 + 4); b[0] = (f32x2){x0.x, x0.y}; b[1] = (f32x2){x0.z, x0.w}; b[2] = (f32x2){x1.x, x1.y}; b[3] = (f32x2){x1.z, x1.w}; }
            if (MODE != 0) {
                const f32x4 x0 = *(const f32x4*)(sk + s * 64 + jg * 8), x1 = *(const f32x4*)(sk + s * 64 + jg * 8 + 4); k[0] = (f32x2){x0.x, x0.y}; k[1] = (f32x2){x0.z, x0.w}; k[2] = (f32x2){x1.x, x1.y}; k[3] = (f32x2){x1.z, x1.w};
                const f32x4 v0 = *(const f32x4*)(sv + s * 64 + row0); v[0] = v0.x; v[1] = v0.y; v[2] = v0.z; v[3] = v0.w;
                if (RI == 8) { const f32x4 v1 = *(const f32x4*)(sv + s * 64 + row0 + 4); v[4] = v1.x; v[5] = v1.y; v[6] = v1.z; v[7] = v1.w; }
            }
            if (MODE == 2) { const f32x4 x0 = *(const f32x4*)(sr + s * 64 + jg * 8), x1 = *(const f32x4*)(sr + s * 64 + jg * 8 + 4); r[0] = (f32x2){x0.x, x0.y}; r[1] = (f32x2){x0.z, x0.w}; r[2] = (f32x2){x1.x, x1.y}; r[3] = (f32x2){x1.z, x1.w}; }
            float yk = 0.f;
            float sa[RI];
#pragma unroll
            for (int ri = 0; ri < RI; ++ri) {
                f32x2 a2 = S[ri][0] * na[0], a3 = S[ri][1] * na[1];
                a2 += S[ri][2] * na[2]; a3 += S[ri][3] * na[3]; a2 += a3;
                sa[ri] = a2.x + a2.y;
            }
#pragma unroll
            for (int ri = 0; ri < RI; ++ri) sa[ri] += dppf<0xB1>(sa[ri]);
#pragma unroll
            for (int ri = 0; ri < RI; ++ri) sa[ri] += dppf<0x4E>(sa[ri]);
#pragma unroll
            for (int ri = 0; ri < RI; ++ri) sa[ri] += dppf<0x141>(sa[ri]);
#pragma unroll
            for (int ri = 0; ri < RI; ++ri) {
#pragma unroll
                for (int jj = 0; jj < 4; ++jj) { f32x2 tmp = b[jj] * sa[ri]; if (MODE != 0) tmp += k[jj] * v[ri]; S[ri][jj] = S[ri][jj] * w[jj] + tmp; }
            }
            if (MODE == 2) {
                float ys[RI];
#pragma unroll
                for (int ri = 0; ri < RI; ++ri) {
                    f32x2 y2 = S[ri][0] * r[0], y3 = S[ri][1] * r[1];
                    y2 += S[ri][2] * r[2]; y3 += S[ri][3] * r[3]; y2 += y3;
                    ys[ri] = y2.x + y2.y;
                }
#pragma unroll
                for (int ri = 0; ri < RI; ++ri) ys[ri] += dppf<0xB1>(ys[ri]);
#pragma unroll
                for (int ri = 0; ri < RI; ++ri) ys[ri] += dppf<0x4E>(ys[ri]);
#pragma unroll
                for (int ri = 0; ri < RI; ++ri) ys[ri] += dppf<0x141>(ys[ri]);
#pragma unroll
                for (int ri = 0; ri < RI; ++ri) yk = (jg == ri) ? ys[ri] : yk;
            }
            if (MODE == 2) { if (RI == 8 || jg < 4) proj[(size_t)(tbase + blk * TBK + s) * PLD + PC_K + head * 64 + row0 + jg] = f2bf(yk); }
        }
    }
    if (MODE != 2) {
        float* dp = (float*)(P.ws + (MODE == 0 ? WS_RT : WS_RL)) + ((size_t)(head * NSEG + seg) * 64 + row0) * 64 + jg * 8;
#pragma unroll
        for (int ri = 0; ri < RI; ++ri) { *(f32x4*)(dp + ri * 64) = (f32x4){S[ri][0].x, S[ri][0].y, S[ri][1].x, S[ri][1].y}; *(f32x4*)(dp + ri * 64 + 4) = (f32x4){S[ri][2].x, S[ri][2].y, S[ri][3].x, S[ri][3].y}; }
    }
}

template <int MODE>
__device__ __forceinline__ void gdn_job(const Params& P, float* lw, int head, int rb, int seg) {
    float* sk = lw; float* sq = lw + 1024; float* sv = lw + 2048; float* sal = lw + 2304; float* sbe = lw + 2312;
    bf16_t* proj = (bf16_t*)(P.ws + WS_BIG);
    const bf16_t* gp = (const bf16_t*)(P.ws + WS_GDNP); const float* gbeta = (const float*)(P.ws + WS_GBETA); const float* gg = (const float*)(P.ws + WS_GG);
    const int lane = threadIdx.x & 63, jg = lane & 7, ig = lane >> 3, qh = head >> 1;
    const int ltt = lane >> 3, lc16 = (lane & 7) * 16, lc4 = (lane & 7) * 4;
    const int row0 = rb * 32 + ig * 4;
    f32x2 S[4][8];
    if constexpr (MODE == 2) {
        const float* sp = (const float*)((const unsigned char*)P.out + 96 * MiB) + ((size_t)(head * NSEG + seg) * 128 + row0) * 128 + jg * 16;
#pragma unroll
        for (int ri = 0; ri < 4; ++ri)
#pragma unroll
            for (int q4 = 0; q4 < 4; ++q4) { const f32x4 a = *(const f32x4*)(sp + ri * 128 + q4 * 4); S[ri][2 * q4] = (f32x2){a.x, a.y}; S[ri][2 * q4 + 1] = (f32x2){a.z, a.w}; }
    } else {
#pragma unroll
        for (int ri = 0; ri < 4; ++ri)
#pragma unroll
            for (int jj = 0; jj < 8; ++jj) { S[ri][jj] = (f32x2){0.f, 0.f}; if (MODE == 0) { if (row0 + ri == jg * 16 + 2 * jj) S[ri][jj].x = 1.f; if (row0 + ri == jg * 16 + 2 * jj + 1) S[ri][jj].y = 1.f; } }
    }
    u32x4 g_k0, g_k1, g_q0, g_q1; u32x2 g_v; float g_al = 0.f, g_be = 0.f;
    const int tbase = seg * SEGLEN;
    auto issue = [&](int blk) {
        const int t = tbase + blk * TBK + ltt;
        const bf16_t* rowp = gp + (size_t)t * 2048;
        g_k0 = *(const u32x4*)(rowp + 512 + qh * 128 + lc16); g_k1 = *(const u32x4*)(rowp + 512 + qh * 128 + lc16 + 8);
        if (MODE == 2) { g_q0 = *(const u32x4*)(rowp + qh * 128 + lc16); g_q1 = *(const u32x4*)(rowp + qh * 128 + lc16 + 8); }
        if (MODE != 0) g_v = *(const u32x2*)(rowp + 1024 + head * 128 + rb * 32 + lc4);
        if (lane < TBK) { const int tq = tbase + blk * TBK + lane; g_al = gg[tq * 8 + head]; g_be = gbeta[tq * 8 + head]; }
    };
    issue(0);
    for (int blk = 0; blk < SEGLEN / TBK; ++blk) {
        {
            float a[8], b[8];
            UNPK8(a, g_k0); UNPK8(b, g_k1);
            *(f32x4*)(sk + ltt * 128 + lc16) = (f32x4){a[0], a[1], a[2], a[3]}; *(f32x4*)(sk + ltt * 128 + lc16 + 4) = (f32x4){a[4], a[5], a[6], a[7]};
            *(f32x4*)(sk + ltt * 128 + lc16 + 8) = (f32x4){b[0], b[1], b[2], b[3]}; *(f32x4*)(sk + ltt * 128 + lc16 + 12) = (f32x4){b[4], b[5], b[6], b[7]};
            if (MODE == 2) {
                UNPK8(a, g_q0); UNPK8(b, g_q1);
                *(f32x4*)(sq + ltt * 128 + lc16) = (f32x4){a[0], a[1], a[2], a[3]}; *(f32x4*)(sq + ltt * 128 + lc16 + 4) = (f32x4){a[4], a[5], a[6], a[7]};
                *(f32x4*)(sq + ltt * 128 + lc16 + 8) = (f32x4){b[0], b[1], b[2], b[3]}; *(f32x4*)(sq + ltt * 128 + lc16 + 12) = (f32x4){b[4], b[5], b[6], b[7]};
            }
            if (MODE != 0) *(f32x4*)(sv + ltt * 32 + lc4) = (f32x4){bflo(g_v.x), bfhi(g_v.x), bflo(g_v.y), bfhi(g_v.y)};
            if (lane < TBK) { sal[lane] = __expf(g_al); sbe[lane] = g_be; }
        }
        if (blk + 1 < SEGLEN / TBK) issue(blk + 1);
#pragma unroll 2
        for (int s = 0; s < TBK; ++s) {
            f32x2 k[8], q[8]; f32x4 v = {0.f, 0.f, 0.f, 0.f};
#pragma unroll
            for (int q4 = 0; q4 < 4; ++q4) { const f32x4 x = *(const f32x4*)(sk + s * 128 + jg * 16 + q4 * 4); k[2 * q4] = (f32x2){x.x, x.y}; k[2 * q4 + 1] = (f32x2){x.z, x.w}; }
            if (MODE == 2) {
#pragma unroll
                for (int q4 = 0; q4 < 4; ++q4) { const f32x4 x = *(const f32x4*)(sq + s * 128 + jg * 16 + q4 * 4); q[2 * q4] = (f32x2){x.x, x.y}; q[2 * q4 + 1] = (f32x2){x.z, x.w}; }
            }
            if (MODE != 0) v = *(const f32x4*)(sv + s * 32 + ig * 4);
            const float al = sal[s], be = sbe[s];
            float ok = 0.f;
            float sa[4];
#pragma unroll
            for (int ri = 0; ri < 4; ++ri) {
                f32x2 a2 = S[ri][0] * k[0], a3 = S[ri][1] * k[1];
#pragma unroll
                for (int jj = 2; jj < 8; jj += 2) { a2 += S[ri][jj] * k[jj]; a3 += S[ri][jj + 1] * k[jj + 1]; }
                a2 += a3; sa[ri] = a2.x + a2.y;
            }
#pragma unroll
            for (int ri = 0; ri < 4; ++ri) sa[ri] += dppf<0xB1>(sa[ri]);
#pragma unroll
            for (int ri = 0; ri < 4; ++ri) sa[ri] += dppf<0x4E>(sa[ri]);
#pragma unroll
            for (int ri = 0; ri < 4; ++ri) sa[ri] += dppf<0x141>(sa[ri]);
#pragma unroll
            for (int ri = 0; ri < 4; ++ri) {
                const float c = (MODE != 0) ? be * (v[ri] - al * sa[ri]) : -be * al * sa[ri];
#pragma unroll
                for (int jj = 0; jj < 8; ++jj) S[ri][jj] = S[ri][jj] * al + k[jj] * c;
            }
            if (MODE == 2) {
                float os[4];
#pragma unroll
                for (int ri = 0; ri < 4; ++ri) {
                    f32x2 o2 = S[ri][0] * q[0], o3 = S[ri][1] * q[1];
#pragma unroll
                    for (int jj = 2; jj < 8; jj += 2) { o2 += S[ri][jj] * q[jj]; o3 += S[ri][jj + 1] * q[jj + 1]; }
                    o2 += o3; os[ri] = o2.x + o2.y;
                }
#pragma unroll
                for (int ri = 0; ri < 4; ++ri) os[ri] += dppf<0xB1>(os[ri]);
#pragma unroll
                for (int ri = 0; ri < 4; ++ri) os[ri] += dppf<0x4E>(os[ri]);
#pragma unroll
                for (int ri = 0; ri < 4; ++ri) os[ri] += dppf<0x141>(os[ri]);
#pragma unroll
                for (int ri = 0; ri < 4; ++ri) ok = (jg == ri) ? os[ri] : ok;
            }
            if (MODE == 2) { if (jg < 4) proj[(size_t)(tbase + blk * TBK + s) * PLD + PC_GQKV + head * 128 + row0 + jg] = f2bf(ok); }
        }
    }
    if (MODE != 2) {
        float* dp = (float*)((unsigned char*)P.out + (MODE == 0 ? 64 * MiB : 96 * MiB)) + ((size_t)(head * NSEG + seg) * 128 + row0) * 128 + jg * 16;
#pragma unroll
        for (int ri = 0; ri < 4; ++ri)
#pragma unroll
            for (int q4 = 0; q4 < 4; ++q4) *(f32x4*)(dp + ri * 128 + q4 * 4) = (f32x4){S[ri][2 * q4].x, S[ri][2 * q4].y, S[ri][2 * q4 + 1].x, S[ri][2 * q4 + 1].y};
    }
}

template <int N>
__device__ __forceinline__ void combine_job(const float* Tm, float* Lm, unsigned char* lds_, int head, int rg) {
    constexpr int NV = N * N / 4 / 512;
    constexpr int RT = (N == 128) ? 2 : 1;
    constexpr int NCQ = N / 4;
    constexpr int JQ = N / 4;
    float* Tl = (float*)lds_;
    float* cl = Tl + N * N;
    float* pl = cl + 8 * N;
    const int tid = threadIdx.x;
    const int cq = tid % NCQ, rp = (tid / NCQ) % (8 / RT), jq = tid / (NCQ * (8 / RT));
    const int ri = tid >> 6, c = tid & 63;
    float cur0 = 0.f, cur1 = 0.f;
    f32x4 tv[NV]; float l0, l1 = 0.f;
    {
        const size_t base = (size_t)(head * NSEG) * N * N;
#pragma unroll
        for (int i = 0; i < NV; ++i) tv[i] = *(const f32x4*)(Tm + base + (size_t)(tid + 512 * i) * 4);
        l0 = Lm[base + (size_t)(rg * 8 + ri) * N + c]; if (N == 128) l1 = Lm[base + (size_t)(rg * 8 + ri) * N + c + 64];
    }
    for (int g = 0; g < NSEG; ++g) {
        const size_t base = (size_t)(head * NSEG + g) * N * N;
        __syncthreads();
#pragma unroll
        for (int i = 0; i < NV; ++i) *(f32x4*)(Tl + (size_t)(tid + 512 * i) * 4) = tv[i];
        cl[ri * N + c] = cur0; if (N == 128) cl[ri * N + c + 64] = cur1;
        const float a0 = l0, a1 = l1;
        if (g + 1 < NSEG) {
            const size_t nb = base + (size_t)N * N;
#pragma unroll
            for (int i = 0; i < NV; ++i) tv[i] = *(const f32x4*)(Tm + nb + (size_t)(tid + 512 * i) * 4);
            l0 = Lm[nb + (size_t)(rg * 8 + ri) * N + c]; if (N == 128) l1 = Lm[nb + (size_t)(rg * 8 + ri) * N + c + 64];
        }
        __syncthreads();
        f32x4 acc[RT];
#pragma unroll
        for (int r = 0; r < RT; ++r) acc[r] = (f32x4){0.f, 0.f, 0.f, 0.f};
#pragma unroll 2
        for (int j4 = 0; j4 < JQ / 4; ++j4) {
            const int j0 = jq * JQ + j4 * 4;
            f32x4 x[RT];
#pragma unroll
            for (int r = 0; r < RT; ++r) x[r] = *(const f32x4*)(cl + (rp * RT + r) * N + j0);
#pragma unroll
            for (int e = 0; e < 4; ++e) {
                const f32x4 t4 = *(const f32x4*)(Tl + (j0 + e) * N + cq * 4);
#pragma unroll
                for (int r = 0; r < RT; ++r) acc[r] += t4 * x[r][e];
            }
        }
#pragma unroll
        for (int r = 0; r < RT; ++r) *(f32x4*)(pl + (jq * 8 + rp * RT + r) * N + cq * 4) = acc[r];
        __syncthreads();
        float s0 = a0 + ((pl[(0 * 8 + ri) * N + c] + pl[(1 * 8 + ri) * N + c]) + (pl[(2 * 8 + ri) * N + c] + pl[(3 * 8 + ri) * N + c]));
        float s1 = 0.f;
        if (N == 128) s1 = a1 + ((pl[(0 * 8 + ri) * N + c + 64] + pl[(1 * 8 + ri) * N + c + 64]) + (pl[(2 * 8 + ri) * N + c + 64] + pl[(3 * 8 + ri) * N + c + 64]));
        float* lp = Lm + base + (size_t)(rg * 8 + ri) * N + c;
        lp[0] = cur0; if (N == 128) lp[64] = cur1;
        cur0 = s0; cur1 = s1;
    }
}

__device__ __forceinline__ void mixer_post(const Params& P, int wg, int nwg, bool dry) {
    bf16_t* proj = (bf16_t*)(P.ws + WS_BIG);
    const bf16_t* i_kp = (const bf16_t*)(P.ws + WS_RWP) + (size_t)T * 1024; const bf16_t* i_g = (const bf16_t*)(P.ws + WS_RWG);
    const float* mu = P.in[8]; const float* r_k = P.in[16]; const float* ln_w = P.in[17]; const float* ln_b = P.in[18]; const float* gnw = P.in[22];
    const int lane = threadIdx.x & 63, wid = threadIdx.x >> 6;
    const int gw = wg * 8 + wid, ngw = nwg * 8;
    const int sub = lane >> 4, l16 = lane & 15;
    for (int it0 = gw * 4; it0 < T * 16; it0 += ngw * 4) {
        const int it = it0 + sub, t = it >> 4, hh = it & 15, c = hh * 64 + l16 * 4;
        const size_t pr = (size_t)t * PLD;
        const u32x2 yu = *(const u32x2*)(proj + pr + PC_K + c), rcu = *(const u32x2*)(proj + pr + PC_R + c), vcu = *(const u32x2*)(proj + pr + PC_V + c);
        u32x2 rpu = {0u, 0u}, vpu = {0u, 0u};
        if (t > 0) { rpu = *(const u32x2*)(proj + pr - PLD + PC_R + c); vpu = *(const u32x2*)(proj + pr - PLD + PC_V + c); }
        const u32x2 kpu = *(const u32x2*)(i_kp + (size_t)t * 1024 + c), ggu = *(const u32x2*)(i_g + (size_t)t * 1024 + c);
        const f32x4 mur = *(const f32x4*)(mu + c), muv = *(const f32x4*)(mu + 2048 + c), rk = *(const f32x4*)(r_k + c), lw = *(const f32x4*)(ln_w + c), lb = *(const f32x4*)(ln_b + c);
        const f32x4 y = {bflo(yu.x), bfhi(yu.x), bflo(yu.y), bfhi(yu.y)}, rc = {bflo(rcu.x), bfhi(rcu.x), bflo(rcu.y), bfhi(rcu.y)}, vc = {bflo(vcu.x), bfhi(vcu.x), bflo(vcu.y), bfhi(vcu.y)};
        const f32x4 rp = {bflo(rpu.x), bfhi(rpu.x), bflo(rpu.y), bfhi(rpu.y)}, vp = {bflo(vpu.x), bfhi(vpu.x), bflo(vpu.y), bfhi(vpu.y)};
        const f32x4 kp = {bflo(kpu.x), bfhi(kpu.x), bflo(kpu.y), bfhi(kpu.y)}, gg = {bflo(ggu.x), bfhi(ggu.x), bflo(ggu.y), bfhi(ggu.y)};
        const float mean = red16(y.x + y.y + y.z + y.w) * (1.f / 64.f);
        const f32x4 d = y - mean;
        const float var = red16(d.x * d.x + d.y * d.y + d.z * d.z + d.w * d.w) * (1.f / 64.f);
        const f32x4 r = rc + (rp - rc) * mur, v = vc + (vp - vc) * muv;
        const f32x4 rkk = r * kp * rk;
        const float bs = red16(rkk.x + rkk.y + rkk.z + rkk.w);
        const f32x4 o = (d * rsqrtf(var + 64e-5f) * lw + lb + v * bs) * gg;
        if (!dry || o.x != o.x) { u32x2 w; w.x = cvt_pk_bf16(o.x, o.y); w.y = cvt_pk_bf16(o.z, o.w); *(u32x2*)(proj + pr + PC_K + c) = w; }
    }
    for (int it0 = gw * 4; it0 < T * 8; it0 += ngw * 4) {
        const int it = it0 + sub, t = it >> 3, hh = it & 7, c = hh * 128 + l16 * 8;
        const size_t pr = (size_t)t * PLD;
        const u32x4 ou = *(const u32x4*)(proj + pr + PC_GQKV + c), zu = *(const u32x4*)(proj + pr + PC_Z + c);
        const f32x4 w0 = *(const f32x4*)(gnw + l16 * 8), w1 = *(const f32x4*)(gnw + l16 * 8 + 4);
        float o[8], z[8];
        UNPK8(o, ou); UNPK8(z, zu);
        float ss = 0.f;
#pragma unroll
        for (int e = 0; e < 8; ++e) ss += o[e] * o[e];
        ss = red16(ss);
        const float rs = rsqrtf(ss * (1.f / 128.f) + 1e-6f);
        float q[8];
#pragma unroll
        for (int e = 0; e < 8; ++e) q[e] = o[e] * rs * (e < 4 ? w0[e] : w1[e - 4]) * siluf_(z[e]);
        if (!dry || q[0] != q[0]) { u32x4 w; w.x = cvt_pk_bf16(q[0], q[1]); w.y = cvt_pk_bf16(q[2], q[3]); w.z = cvt_pk_bf16(q[4], q[5]); w.w = cvt_pk_bf16(q[6], q[7]); *(u32x4*)(proj + pr + PC_GQKV + c) = w; }
    }
}

constexpr size_t WS_KF = WS_BIG + 131 * MiB, WS_VF = WS_BIG + 132 * MiB;
__device__ __forceinline__ void attn_reformat(const bf16_t* Km, const bf16_t* Vt, bf16_t* Kf, bf16_t* Vf, int wg, int nwg) {
    for (int idx = wg * 512 + threadIdx.x; idx < 2 * 65536; idx += nwg * 512) {
        const int which = idx >> 16, li = idx & 65535, lane = li & 63, frag = li >> 6, r = lane & 15, qd = lane >> 4;
        if (which == 0) {
            const int ks = frag & 15, mt = (frag >> 4) & 15, hd = frag >> 8;
            *(u32x4*)(Kf + (size_t)li * 8) = *(const u32x4*)(Km + (size_t)(16 * mt + r) * D + 512 * hd + 32 * ks + 8 * qd);
        } else {
            const int s8 = frag & 7, dt = (frag >> 3) & 31, hd = frag >> 8;
            const bf16_t* vrow = Vt + (size_t)(512 * hd + 16 * dt + r) * NMEM;
            const u32x2 lo = *(const u32x2*)(vrow + 32 * s8 + 4 * qd), hi = *(const u32x2*)(vrow + 32 * s8 + 16 + 4 * qd);
            *(u32x4*)(Vf + (size_t)li * 8) = (u32x4){lo.x, lo.y, hi.x, hi.y};
        }
    }
}
__device__ __forceinline__ void attn_phase(const bf16_t* q, const bf16_t* Kf, const bf16_t* Vf, bf16_t* o, unsigned char* lds_, int wg, int nwg) {
    const int tid = threadIdx.x, lane = tid & 63, wid = tid >> 6, r = lane & 15, qd = lane >> 4;
    const float scale = 0.04419417382415922f * 1.4426950408889634f;
    u32x4* lb = (u32x4*)lds_;
    const int nitems = (T / 128) * 4;
    u32x4 pre[8];
    auto chunk_src = [&](int item, int ci) -> const u32x4* {
        const int hd = item & 3;
        return ci < 4 ? (const u32x4*)Kf + (size_t)((hd * 16 + 4 * ci) * 16) * 64 : (const u32x4*)Vf + (size_t)((hd * 32 + 8 * (ci - 4)) * 8) * 64;
    };
    if (wg >= nitems) return;
    { const u32x4* p = chunk_src(wg, 0);
#pragma unroll
      for (int i = 0; i < 8; ++i) lb[tid + 512 * i] = p[tid + 512 * i]; }
    __syncthreads();
    for (int item = wg; item < nitems; item += nwg) {
        const int hd = item & 3, t0 = (item >> 2) * 128 + wid * 16;
        const bool last_item = (item + nwg >= nitems);
        bf16x8 qf[16];
#pragma unroll
        for (int ks = 0; ks < 16; ++ks) qf[ks] = *(const bf16x8*)(q + (size_t)(t0 + r) * D + hd * 512 + ks * 32 + qd * 8);
        f32x4 s[16];
        bf16x8 pf[8];
        float inv = 0.f;
#pragma unroll
        for (int ci = 0; ci < 8; ++ci) {
            const bool has_next = !(last_item && ci == 7);
            if (has_next) { const u32x4* p = (ci < 7) ? chunk_src(item, ci + 1) : chunk_src(item + nwg, 0);
#pragma unroll
                for (int i = 0; i < 8; ++i) pre[i] = p[tid + 512 * i]; }
            const u32x4* cb = lb + (ci & 1) * 4096;
            if (ci < 4) {
#pragma unroll
                for (int m4 = 0; m4 < 4; ++m4) {
                    f32x4 acc = {0.f, 0.f, 0.f, 0.f};
#pragma unroll
                    for (int ks = 0; ks < 16; ++ks) acc = __builtin_amdgcn_mfma_f32_16x16x32_bf16(__builtin_bit_cast(bf16x8, cb[(m4 * 16 + ks) * 64 + lane]), qf[ks], acc, 0, 0, 0);
                    s[ci * 4 + m4] = acc;
                }
                if (ci == 3) {
                    float mx = -3.0e38f;
#pragma unroll
                    for (int mt = 0; mt < 16; ++mt) mx = fmaxf(mx, fmaxf(fmaxf(s[mt].x, s[mt].y), fmaxf(s[mt].z, s[mt].w)));
                    mx = fmaxf(mx, __shfl_xor(mx, 16)); mx = fmaxf(mx, __shfl_xor(mx, 32));
                    float sum = 0.f;
#pragma unroll
                    for (int mt = 0; mt < 16; ++mt) {
#pragma unroll
                        for (int e = 0; e < 4; ++e) { const float p = exp2f((s[mt][e] - mx) * scale); s[mt][e] = p; sum += p; }
                    }
                    sum += __shfl_xor(sum, 16); sum += __shfl_xor(sum, 32);
                    inv = 1.f / sum;
#pragma unroll
                    for (int s8 = 0; s8 < 8; ++s8) {
                        u32x4 w; w.x = cvt_pk_bf16(s[2 * s8].x, s[2 * s8].y); w.y = cvt_pk_bf16(s[2 * s8].z, s[2 * s8].w); w.z = cvt_pk_bf16(s[2 * s8 + 1].x, s[2 * s8 + 1].y); w.w = cvt_pk_bf16(s[2 * s8 + 1].z, s[2 * s8 + 1].w);
                        pf[s8] = __builtin_bit_cast(bf16x8, w);
                    }
                }
            } else {
                const int dg = ci - 4;
#pragma unroll
                for (int dt = 0; dt < 8; ++dt) {
                    f32x4 oa = {0.f, 0.f, 0.f, 0.f};
#pragma unroll
                    for (int s8 = 0; s8 < 8; ++s8) oa = __builtin_amdgcn_mfma_f32_16x16x32_bf16(__builtin_bit_cast(bf16x8, cb[(dt * 8 + s8) * 64 + lane]), pf[s8], oa, 0, 0, 0);
                    u32x2 w; w.x = cvt_pk_bf16(oa.x * inv, oa.y * inv); w.y = cvt_pk_bf16(oa.z * inv, oa.w * inv);
                    *(u32x2*)(o + (size_t)(t0 + r) * D + hd * 512 + dg * 128 + dt * 16 + qd * 4) = w;
                }
            }
            if (has_next) { u32x4* nb = lb + ((ci + 1) & 1) * 4096;
#pragma unroll
                for (int i = 0; i < 8; ++i) nb[tid + 512 * i] = pre[i]; }
            __syncthreads();
        }
    }
}

#define XB_TMO      128
#define XB_XCNT(j)  (256  + 64 * (j))
#define XB_XSUB(j)  (1280 + 64 * (j))
#define XB_XGEN(j)  (2304 + 64 * (j))
#define XB_TOP      3328
#define XB_TOPGEN   3392
#define XCD_BAR_WORDS 3456
#define XB_SPIN_CAP (1u << 18)

__device__ __forceinline__ unsigned xb_ld(unsigned* p)              { return __hip_atomic_load(p, __ATOMIC_RELAXED, __HIP_MEMORY_SCOPE_AGENT); }
__device__ __forceinline__ unsigned xb_add(unsigned* p, unsigned v) { return __hip_atomic_fetch_add(p, v, __ATOMIC_RELAXED, __HIP_MEMORY_SCOPE_AGENT); }
__device__ __forceinline__ unsigned xb_xcc_id() { return (unsigned)__builtin_amdgcn_s_getreg((3 << 11) | 20) & 0xFu; }
#define XB_SPIN(cond, bar) do { unsigned _sp = 0; while (cond) { __builtin_amdgcn_s_sleep(1); \
    if ((++_sp & 255u) == 0u) { if (xb_ld(&(bar)[XB_TMO])) break; if (_sp > XB_SPIN_CAP) { atomicAdd(&(bar)[XB_TMO], 1u); break; } } } } while (0)

struct XcdBarrier {
    unsigned* bar; unsigned x;
    volatile LAS unsigned* st;
};

__device__ __forceinline__ XcdBarrier xcd_barrier_post(unsigned* bar, volatile LAS unsigned* st) {
    XcdBarrier b; b.bar = bar; b.x = xb_xcc_id(); b.st = st;
    if (threadIdx.x == 0) (void)xb_add(&bar[XB_XCNT(b.x)], 1u);
    return b;
}
__device__ __forceinline__ void xcd_barrier_complete(unsigned* bar, unsigned x, unsigned& nloc, unsigned& nx) {
    const unsigned G = gridDim.x * gridDim.y * gridDim.z;
    unsigned sum, cnt, mine, sp = 0u;
    for (;;) {
        sum = 0u; cnt = 0u; mine = 0u;
#pragma unroll
        for (unsigned j = 0; j < 16; ++j) { const unsigned c = xb_ld(&bar[XB_XCNT(j)]); sum += c; cnt += (c > 0u) ? 1u : 0u; mine = (j == x) ? c : mine; }
        if (sum == G) break;
        __builtin_amdgcn_s_sleep(1);
        if ((++sp & 255u) == 0u) { if (xb_ld(&bar[XB_TMO])) break; if (sp > XB_SPIN_CAP) { atomicAdd(&bar[XB_TMO], 1u); break; } }
    }
    nloc = mine > 0u ? mine : 1u; nx = cnt > 0u ? cnt : 1u;
}

__device__ __forceinline__ void xcd_barrier(const XcdBarrier& b) {
    asm volatile("s_waitcnt vmcnt(0)" ::: "memory");
    __syncthreads();
    if (threadIdx.x == 0) {
        unsigned* bar = b.bar;
        __builtin_amdgcn_s_waitcnt(0);
        unsigned nloc = b.st[0], nx = b.st[1];
        if (nloc == 0u) { xcd_barrier_complete(bar, b.x, nloc, nx); b.st[0] = nloc; b.st[1] = nx; }
        const unsigned old = xb_add(&bar[XB_XSUB(b.x)], 1u);
        const unsigned gen = old / nloc;
        if (old + 1u == (gen + 1u) * nloc) {
            __builtin_amdgcn_fence(__ATOMIC_RELEASE, "agent");
            asm volatile("s_waitcnt vmcnt(0)" ::: "memory");
            const unsigned og = xb_add(&bar[XB_TOP], 1u);
            const unsigned tg = og / nx;
            if (og + 1u == (tg + 1u) * nx) xb_add(&bar[XB_TOPGEN], 1u);
            else XB_SPIN(xb_ld(&bar[XB_TOPGEN]) == tg, bar);
            __builtin_amdgcn_fence(__ATOMIC_ACQUIRE, "agent");
            xb_add(&bar[XB_XGEN(b.x)], 1u);
            asm volatile("s_waitcnt vmcnt(0)" ::: "memory");
        } else {
            XB_SPIN(xb_ld(&bar[XB_XGEN(b.x)]) == gen, bar);
            __builtin_amdgcn_fence(__ATOMIC_ACQUIRE, "agent");
            asm volatile("s_waitcnt vmcnt(0)" ::: "memory");
        }
    }
    __syncthreads();
}


__global__ void __launch_bounds__(512, 2) fwd_megakernel(Params P) {
    extern __shared__ __attribute__((aligned(16))) unsigned char smem[];
    LAS unsigned char* lds = (LAS unsigned char*)smem;
    cg::grid_group grid = cg::this_grid();
    const int wg = blockIdx.x, nwg = gridDim.x;
    unsigned char* ws = P.ws;
    bf16_t* hb = (bf16_t*)P.out;
    bf16_t* hb2 = (bf16_t*)(ws + WS_RWP);
    bf16_t* dlt = (bf16_t*)(ws + WS_RWP + 64 * MiB);
    bf16_t* act = (bf16_t*)(ws + WS_ACT);
    bf16_t* big = (bf16_t*)(ws + WS_BIG);
    bf16_t* gates = (bf16_t*)(ws + WS_RWP);
    volatile LAS unsigned* bst = (volatile LAS unsigned*)(lds + STAGE_BYTES);
    if (threadIdx.x == 0) { bst[0] = 0u; bst[1] = 0u; }
    __syncthreads();
    const XcdBarrier xb = xcd_barrier_post((unsigned*)(ws + WS_BAR), bst);

    convert_w(smem, P.in[3], P.in[4], P.in[2], (bf16_t*)(ws + WS_WGU), D, 2 * DFF, DFF, 1, wg, nwg);
    convert_w(smem, P.in[5], nullptr, nullptr, (bf16_t*)(ws + WS_WD), DFF, D, D, 0, wg, nwg);
    convert_w(smem, P.in[7], nullptr, P.in[6], (bf16_t*)(ws + WS_WIN), D, 10752, 10544, 2, wg, nwg);
    convert_w(smem, P.in[23], nullptr, nullptr, (bf16_t*)(ws + WS_LIFT), 1024, D, D, 0, wg, nwg);
    convert_w(smem, P.in[23] + (size_t)1024 * D, nullptr, nullptr, (bf16_t*)(ws + WS_LIFT) + (size_t)D * 1024, 1024, D, D, 0, wg, nwg);
    rownorm_bf16(P.in[0], act, T, wg, nwg);
    lora_frags(P, wg, nwg);
    xcd_barrier(xb);
    run_gemm<0>(lds, act, D, (const bf16_t*)(ws + WS_WGU), T, 2 * DFF, D, big, DFF, nullptr, 0, 0.f, 0);
    xcd_barrier(xb);
    run_gemm<2>(lds, big, DFF, (const bf16_t*)(ws + WS_WD), T, D, DFF, act, D, nullptr, 0, 0.f, 0);
    xcd_barrier(xb);
    rownorm_xd(P.in[0], act, 0.5f, hb, act, T, wg, nwg);
    xcd_barrier(xb);
    run_gemm<2>(lds, act, D, (const bf16_t*)(ws + WS_WIN), T, PLD, D, big, PLD, nullptr, 0, 0.f, 0);
    xcd_barrier(xb);
    rwkv_prep(P, smem, wg, nwg);
    gdn_prep(P, wg, nwg);
    xcd_barrier(xb);
    {
        const int wid = threadIdx.x >> 6, gw = wg * 8 + wid, ngw = nwg * 8;
        float* lw = (float*)(smem + wid * WAVE_LDS);
        for (int j = gw; j < 2048; j += ngw) gdn_job<0>(P, lw, ((j >> 9) << 1) | ((j >> 2) & 1), j & 3, (j >> 3) & 63);
        for (int j = gw; j < 2048; j += ngw) gdn_job<1>(P, lw, ((j >> 9) << 1) | ((j >> 2) & 1), j & 3, (j >> 3) & 63);
        for (int j = gw; j < 2048; j += ngw) { if (j & 1) rwkv_job<1, 8>(P, lw, j >> 7, (j >> 1) & 63, 0); else rwkv_job<0, 8>(P, lw, j >> 7, (j >> 1) & 63, 0); }
    }
    xcd_barrier(xb);
    for (int j = wg; j < 256; j += nwg) {
        if (j < 128) combine_job<64>((const float*)(ws + WS_RT), (float*)(ws + WS_RL), smem, j >> 3, j & 7);
        else combine_job<128>((const float*)((unsigned char*)P.out + 64 * MiB), (float*)((unsigned char*)P.out + 96 * MiB), smem, (j - 128) >> 4, (j - 128) & 15);
    }
    xcd_barrier(xb);
    {
        const int wid = threadIdx.x >> 6, gw = wg * 8 + wid, ngw = nwg * 8;
        float* lw = (float*)(smem + wid * WAVE_LDS);
        for (int j = gw; j < 2048; j += ngw) gdn_job<2>(P, lw, ((j >> 9) << 1) | ((j >> 2) & 1), j & 3, (j >> 3) & 63);
        for (int j = gw; j < 2048; j += ngw) rwkv_job<2, 4>(P, lw, j >> 7, (j >> 1) & 63, j & 1);
    }
    xcd_barrier(xb);
    mixer_post(P, wg, nwg, false);
    xcd_barrier(xb);
    run_gemm<3>(lds, act, D, (const bf16_t*)(ws + WS_WIN) + (size_t)PLD * D, T, 2 * D, D, gates, 2 * D, nullptr, 0, 0.f, 0);
    convert_w(smem, P.in[24], nullptr, nullptr, (bf16_t*)(ws + WS_WOUT), D, D, D, 0, wg, nwg);
    convert_w(smem, P.in[27], nullptr, P.in[25], (bf16_t*)(ws + WS_MQ), D, D, D, 0, wg, nwg);
    convert_w(smem, P.in[28], nullptr, P.in[26], (bf16_t*)(ws + WS_MK), D, D, D, 0, wg, nwg);
    convert_w(smem, P.in[29], nullptr, P.in[26], (bf16_t*)(ws + WS_MV), D, D, D, 0, wg, nwg);
    convert_w(smem, P.in[30], nullptr, nullptr, (bf16_t*)(ws + WS_MO), D, D, D, 0, wg, nwg);
    xcd_barrier(xb);
    run_gemm<4>(lds, big + PC_K, PLD, (const bf16_t*)(ws + WS_LIFT), T, D, 1024, act, D, gates, 2 * D, 0.f, 0);
    convert_w(smem, P.in[32], P.in[33], P.in[31], (bf16_t*)(ws + WS_WGU), D, 2 * DFF, DFF, 1, wg, nwg);
    convert_w(smem, P.in[34], nullptr, nullptr, (bf16_t*)(ws + WS_WD), DFF, D, D, 0, wg, nwg);
    run_gemm<5>(lds, big + PC_GQKV, PLD, (const bf16_t*)(ws + WS_LIFT) + (size_t)D * 1024, T, D, 1024, act, D, gates + D, 2 * D, 0.f, 0);
    xcd_barrier(xb);
    run_gemm<2>(lds, act, D, (const bf16_t*)(ws + WS_WOUT), T, D, D, hb2, D, nullptr, 0, 0.f, 0);
    rownorm_bf16(P.in[1], (bf16_t*)(ws + WS_MKVN), NMEM, wg, nwg);
    xcd_barrier(xb);
    if (wg >= 16) rownorm_bd(hb, hb2, hb, (bf16_t*)(ws + WS_HQ), T, wg - 16, nwg - 16);
    run_gemm<2>(lds, (const bf16_t*)(ws + WS_MKVN), D, (const bf16_t*)(ws + WS_MK), NMEM, D, D, ws + WS_KM, D, nullptr, 0, 0.f, 0);
    run_gemm<2>(lds, (const bf16_t*)(ws + WS_MV), D, (const bf16_t*)(ws + WS_MKVN), D, NMEM, D, ws + WS_VT, NMEM, nullptr, 0, 0.f, 8);
    xcd_barrier(xb);
    attn_reformat((const bf16_t*)(ws + WS_KM), (const bf16_t*)(ws + WS_VT), (bf16_t*)(ws + WS_KF), (bf16_t*)(ws + WS_VF), wg, nwg);
    run_gemm<2>(lds, (const bf16_t*)(ws + WS_HQ), D, (const bf16_t*)(ws + WS_MQ), T, D, D, ws + WS_Q, D, nullptr, 0, 0.f, 0);
    xcd_barrier(xb);
    attn_phase((const bf16_t*)(ws + WS_Q), (const bf16_t*)(ws + WS_KF), (const bf16_t*)(ws + WS_VF), act, smem, wg, nwg);
    xcd_barrier(xb);
    run_gemm<2>(lds, act, D, (const bf16_t*)(ws + WS_MO), T, D, D, dlt, D, nullptr, 0, 0.f, 0);
    xcd_barrier(xb);
    rownorm_bd(hb, dlt, hb2, act, T, wg, nwg);
    xcd_barrier(xb);
    run_gemm<0>(lds, act, D, (const bf16_t*)(ws + WS_WGU), T, 2 * DFF, D, big, DFF, nullptr, 0, 0.f, 0);
    xcd_barrier(xb);
    run_gemm<2>(lds, big, DFF, (const bf16_t*)(ws + WS_WD), T, D, DFF, dlt, D, nullptr, 0, 0.f, 0);
    xcd_barrier(xb);
    final_norm3(hb2, dlt, 0.5f, P.out, P.in[35], T, wg, nwg);
    if (nwg == 0x7fffffff) grid.sync();
}

extern "C" void kernel_launch(void* const* d_in, const int* in_sizes, int n_in, void* d_out, int out_size, void* d_ws, size_t ws_size, hipStream_t stream) {
    static int grid_blocks = 0;
    if (grid_blocks == 0) {
        if (n_in != 36 || out_size != T * D || ws_size < WS_END2 || in_sizes[7] != D * 10544 || in_sizes[8] != 3360) { fprintf(stderr, "kernel_launch: unexpected shapes n_in %d out %d ws %zu (need %zu)\n", n_in, out_size, ws_size, (size_t)WS_END); grid_blocks = -1; return; }
        int dev = 0, cus = 0, per_cu = 0;
        hipGetDevice(&dev);
        hipDeviceGetAttribute(&cus, hipDeviceAttributeMultiprocessorCount, dev);
        if (hipFuncSetAttribute((const void*)fwd_megakernel, hipFuncAttributeMaxDynamicSharedMemorySize, LDS_BYTES) != hipSuccess) { fprintf(stderr, "hipFuncSetAttribute failed\n"); grid_blocks = -1; return; }
        if (hipOccupancyMaxActiveBlocksPerMultiprocessor(&per_cu, (const void*)fwd_megakernel, 512, LDS_BYTES) != hipSuccess || per_cu < 1) { fprintf(stderr, "occupancy query failed (%d)\n", per_cu); per_cu = 1; }
        (void)hipGetLastError();
        grid_blocks = cus * 1;
        if (grid_blocks < 48) { fprintf(stderr, "too few CUs\n"); grid_blocks = -1; return; }
    }
    if (grid_blocks < 0) return;
    Params p{};
    for (int i = 0; i < 36; ++i) p.in[i] = (const float*)d_in[i];
    p.out = (float*)d_out; p.ws = (unsigned char*)d_ws;
    if (hipMemsetAsync((char*)d_ws + WS_BAR, 0, XCD_BAR_WORDS * sizeof(unsigned), stream) != hipSuccess) { fprintf(stderr, "barrier memset failed\n"); return; }
    void* args[] = {&p};
    hipError_t e = hipLaunchCooperativeKernel((void*)fwd_megakernel, dim3(grid_blocks), dim3(512), args, LDS_BYTES, stream);
    if (e != hipSuccess) fprintf(stderr, "cooperative launch failed: %s (grid %d)\n", hipGetErrorString(e), grid_blocks);
}
```
